# Optimizing an MI355X kernel written in HIP

```python
import jax, jax.numpy as jnp
from jax import lax
import numpy as np

D_MODEL = 1024
BATCH = 16
SEQ = 2048
DEPTH = 2
DEC_BATCH = 8
DEC_SEQ = 64
PAST_LEN = 4096

CHUNK = 64
N_A = DEPTH // 2
N_B = DEPTH - N_A
K_A = 128
H_A = D_MODEL // K_A
V_A = D_MODEL // H_A
D_A = H_A * K_A
H_B = 16
D_HB = D_MODEL // H_B
D_FF = 4 * D_MODEL
Q_BLOCK = 128
EPS = 1e-6

kernel_name = "yoco_hgrn2_fox_stream_step"


def _rmsnorm(x, g):
    xf = x.astype(jnp.float32)
    y = xf * lax.rsqrt(jnp.mean(xf * xf, axis=-1, keepdims=True) + EPS)
    return (y * g.astype(jnp.float32)).astype(x.dtype)


def _mlp(xn, w_up, w_down):
    h = jax.nn.relu(xn @ w_up)
    return (h * h) @ w_down


def _gla_chunked(q, k, v, logf, s0, chunk):
    B, T, H, K = q.shape
    V = v.shape[-1]
    N = T // chunk
    q = q.reshape(B, N, chunk, H, K)
    k = k.reshape(B, N, chunk, H, K)
    v = v.reshape(B, N, chunk, H, V)
    bc = jnp.cumsum(logf.reshape(B, N, chunk, H, K), axis=2)
    btot = bc[:, :, -1]
    q_dec = q * jnp.exp(bc)
    k_inv = k * jnp.exp(-bc)
    k_end = k * jnp.exp(btot[:, :, None] - bc)
    mask = jnp.tril(jnp.ones((chunk, chunk), dtype=bool))
    scores = jnp.einsum('bnthk,bnshk->bnhts', q_dec, k_inv)
    scores = jnp.where(mask, scores, 0.0)
    o_intra = jnp.einsum('bnhts,bnshv->bnthv', scores, v)
    u = jnp.einsum('bnshk,bnshv->bnhkv', k_end, v)
    decay = jnp.exp(btot)

    def step(S, inp):
        d, un = inp
        return d[..., None] * S + un, S

    s_fin, s_before = lax.scan(step, s0, (jnp.moveaxis(decay, 1, 0), jnp.moveaxis(u, 1, 0)))
    s_before = jnp.moveaxis(s_before, 0, 1)
    o_inter = jnp.einsum('bnthk,bnhkv->bnthv', q_dec, s_before)
    return (o_intra + o_inter).reshape(B, T, H, V), s_fin


def _hgrn2(xn, w_in, lb, g_norm, w_o, s0, chunk):
    B, T, _ = xn.shape
    p = (xn @ w_in).astype(jnp.float32)
    q, zf, i, g = jnp.split(p, [D_A, 2 * D_A, 3 * D_A], axis=-1)
    lb = lb.reshape(H_A, K_A)
    q = jax.nn.silu(q).reshape(B, T, H_A, K_A)
    zf = zf.reshape(B, T, H_A, K_A)
    f = lb + (1.0 - lb) * jax.nn.sigmoid(zf)
    logf = jnp.log(f)
    k = (1.0 - lb) * jax.nn.sigmoid(-zf)
    i = i.reshape(B, T, H_A, V_A)
    o, s_fin = _gla_chunked(q, k, i, logf, s0, chunk)
    o = o * lax.rsqrt(jnp.mean(o * o, axis=-1, keepdims=True) + EPS) * g_norm.astype(jnp.float32)
    o = o * jax.nn.sigmoid(g.reshape(B, T, H_A, V_A))
    return o.reshape(B, T, H_A * V_A).astype(xn.dtype) @ w_o, s_fin


def _shared_kv(h, norm_kv, w_kv, b_f):
    B, T, _ = h.shape
    p = _rmsnorm(h, norm_kv) @ w_kv
    hd = H_B * D_HB
    k = p[..., :hd].reshape(B, T, H_B, D_HB)
    v = p[..., hd:2 * hd].reshape(B, T, H_B, D_HB)
    logf = jax.nn.log_sigmoid(p[..., 2 * hd:].astype(jnp.float32) + b_f.astype(jnp.float32))
    return k, v, logf


def _fox_attend(q, k, v, F_q, F_k, q_pos, k_pos):
    B, T, H, Dh = q.shape
    qb_len = min(Q_BLOCK, T)
    nb = T // qb_len
    scale = Dh ** -0.5
    qb = jnp.moveaxis(q.reshape(B, nb, qb_len, H, Dh), 1, 0)
    Fb = jnp.moveaxis(F_q.reshape(B, nb, qb_len, H), 1, 0)
    pb = q_pos.reshape(nb, qb_len)
    kf = k.astype(jnp.float32)
    vf = v.astype(jnp.float32)
    Fk_t = jnp.swapaxes(F_k, 1, 2)

    def block(args):
        qi, Fi, pi = args
        s = jnp.einsum('bqhd,bkhd->bhqk', qi.astype(jnp.float32), kf) * scale
        s = s + jnp.swapaxes(Fi, 1, 2)[..., :, None] - Fk_t[:, :, None, :]
        mask = k_pos[None, :] <= pi[:, None]
        s = jnp.where(mask[None, None], s, -jnp.inf)
        pr = jax.nn.softmax(s, axis=-1)
        return jnp.einsum('bhqk,bkhd->bqhd', pr, vf)

    o = lax.map(block, (qb, Fb, pb))
    return jnp.moveaxis(o, 0, 1).reshape(B, T, H, Dh)


def _fox(xn, w_q, w_o, k_all, v_all, F_q, F_k, q_pos, k_pos):
    B, T, _ = xn.shape
    hd = H_B * D_HB
    p = xn @ w_q
    q = p[..., :hd].reshape(B, T, H_B, D_HB)
    g = p[..., hd:].astype(jnp.float32)
    o = _fox_attend(q, k_all, v_all, F_q, F_k, q_pos, k_pos).reshape(B, T, hd)
    o = o * jax.nn.sigmoid(g)
    return o.astype(xn.dtype) @ w_o


def _trunk(x, state0, k_past, v_past, logf_past, prm):
    B, T, _ = x.shape
    chunk = min(CHUNK, T)
    lb_all = jnp.cumsum(jax.nn.softmax(prm['lb_logits'].astype(jnp.float32), axis=0), axis=0)
    states = []
    for l in range(N_A):
        if state0 is None:
            s0 = jnp.zeros((B, H_A, K_A, V_A), jnp.float32)
        else:
            s0 = state0[:, l].astype(jnp.float32)
        o, s_fin = _hgrn2(_rmsnorm(x, prm['norm_a'][l]), prm['w_in_a'][l], lb_all[l],
                          prm['g_norm_a'][l], prm['w_o_a'][l], s0, chunk)
        x = x + o
        x = x + _mlp(_rmsnorm(x, prm['norm_mlp'][l]), prm['w_up'][l], prm['w_down'][l])
        states.append(s_fin)
    k_new, v_new, logf_new = _shared_kv(x, prm['norm_kv'], prm['w_kv'], prm['b_f'])
    if k_past is None:
        P = 0
        k_all, v_all, logf_all = k_new, v_new, logf_new
    else:
        P = k_past.shape[1]
        k_all = jnp.concatenate([k_past.astype(k_new.dtype), k_new], axis=1)
        v_all = jnp.concatenate([v_past.astype(v_new.dtype), v_new], axis=1)
        logf_all = jnp.concatenate([logf_past.astype(jnp.float32), logf_new], axis=1)
    F = jnp.cumsum(logf_all, axis=1)
    F_q = F[:, P:]
    k_pos = jnp.arange(P + T, dtype=jnp.int32)
    q_pos = P + jnp.arange(T, dtype=jnp.int32)
    for j in range(N_B):
        l = N_A + j
        x = x + _fox(_rmsnorm(x, prm['norm_b'][j]), prm['w_q_b'][j], prm['w_o_b'][j],
                     k_all, v_all, F_q, F, q_pos, k_pos)
        x = x + _mlp(_rmsnorm(x, prm['norm_mlp'][l]), prm['w_up'][l], prm['w_down'][l])
    y = _rmsnorm(x, prm['norm_f'])
    return y, jnp.stack(states, axis=1), k_new, v_new, logf_new


def setup_inputs(seed: int = 0) -> dict:
    key = jax.random.key(seed)
    ks = jax.random.split(key, 24)

    def nrm(k, shape, scale):
        return jax.random.normal(k, shape, jnp.float32) * scale

    b_f = jnp.linspace(1.0, 5.0, H_B, dtype=jnp.float32) + nrm(ks[0], (H_B,), 0.1)
    hd = H_B * D_HB
    return {
        'x_prompt': nrm(ks[1], (BATCH, SEQ, D_MODEL), 1.0),
        'x_sample': nrm(ks[2], (DEC_BATCH, DEC_SEQ, D_MODEL), 1.0),
        'state_hgrn': nrm(ks[3], (DEC_BATCH, N_A, H_A, K_A, V_A), 0.1),
        'cache_k': nrm(ks[4], (DEC_BATCH, PAST_LEN, H_B, D_HB), 1.0),
        'cache_v': nrm(ks[5], (DEC_BATCH, PAST_LEN, H_B, D_HB), 1.0),
        'cache_logf': jax.nn.log_sigmoid(b_f + nrm(ks[6], (DEC_BATCH, PAST_LEN, H_B), 1.0)),
        'norm_a': 1.0 + nrm(ks[7], (N_A, D_MODEL), 0.02),
        'w_in_a': nrm(ks[8], (N_A, D_MODEL, 4 * D_A), D_MODEL ** -0.5),
        'lb_logits': nrm(ks[9], (N_A + 1, D_A), 0.1),
        'g_norm_a': 1.0 + nrm(ks[10], (N_A, V_A), 0.02),
        'w_o_a': nrm(ks[11], (N_A, H_A * V_A, D_MODEL), (H_A * V_A) ** -0.5),
        'norm_kv': 1.0 + nrm(ks[12], (D_MODEL,), 0.02),
        'w_kv': nrm(ks[13], (D_MODEL, 2 * hd + H_B), D_MODEL ** -0.5),
        'b_f': b_f,
        'norm_b': 1.0 + nrm(ks[14], (N_B, D_MODEL), 0.02),
        'w_q_b': nrm(ks[15], (N_B, D_MODEL, 2 * hd), D_MODEL ** -0.5),
        'w_o_b': nrm(ks[16], (N_B, hd, D_MODEL), hd ** -0.5),
        'norm_mlp': 1.0 + nrm(ks[17], (DEPTH, D_MODEL), 0.02),
        'w_up': nrm(ks[18], (DEPTH, D_MODEL, D_FF), D_MODEL ** -0.5),
        'w_down': nrm(ks[19], (DEPTH, D_FF, D_MODEL), D_FF ** -0.5),
        'norm_f': 1.0 + nrm(ks[20], (D_MODEL,), 0.02),
    }


def reference(x_prompt, x_sample, state_hgrn, cache_k, cache_v, cache_logf,
              norm_a, w_in_a, lb_logits, g_norm_a, w_o_a,
              norm_kv, w_kv, b_f, norm_b, w_q_b, w_o_b,
              norm_mlp, w_up, w_down, norm_f):
    prm = {
        'norm_a': norm_a, 'w_in_a': w_in_a, 'lb_logits': lb_logits, 'g_norm_a': g_norm_a,
        'w_o_a': w_o_a, 'norm_kv': norm_kv, 'w_kv': w_kv, 'b_f': b_f, 'norm_b': norm_b,
        'w_q_b': w_q_b, 'w_o_b': w_o_b, 'norm_mlp': norm_mlp, 'w_up': w_up,
        'w_down': w_down, 'norm_f': norm_f,
    }
    y_prompt, st_p, k_p, v_p, lf_p = _trunk(x_prompt, None, None, None, None, prm)
    y_sample, st_s, k_s, v_s, lf_s = _trunk(x_sample, state_hgrn, cache_k, cache_v, cache_logf, prm)
    return (y_prompt, y_sample, st_p, k_p, v_p, lf_p, st_s, k_s, v_s, lf_s)
```

```cpp
#include <hip/hip_runtime.h>
#include <cstdio>
#include <cstdint>

constexpr int DM = 1024, FF = 4096;
constexpr int BP = 16, TP = 2048, BS = 8, TS = 64, PAST = 4096;
constexpr int MP = BP * TP, MS = BS * TS, M = MP + MS;
constexpr int HA = 8, KA = 128, HB = 16, DH = 64, CH = 64;
constexpr int SKV = PAST + TS;
constexpr float EPS = 1e-6f;
constexpr float LOG2E = 1.4426950408889634f;
constexpr float QSCALE = 0.125f * LOG2E;

constexpr size_t OY_P = 0, OY_S = 33554432, OST_P = 34078720, OK_P = 36175872, OV_P = 69730304, OLF_P = 103284736,
                 OST_S = 103809024, OK_S = 104857600, OV_S = 105381888, OLF_S = 105906176, OUT_END = 105914368;

constexpr size_t MiB = 1u << 20;
constexpr size_t WS_CTL = 0, CTL_ZERO_BYTES = 1 * MiB;
constexpr size_t WS_LB = 1 * MiB;
constexpr size_t WS_WLF = 1 * MiB + 65536;
constexpr size_t WS_RSSX = 2 * MiB;
constexpr size_t WS_RSSA = 3 * MiB, WS_RSSB = 6 * MiB;
constexpr size_t WS_FS = 11 * MiB;
constexpr size_t WS_WIN = 14 * MiB, WS_WO = 22 * MiB, WS_WUP0 = 24 * MiB, WS_WDN0 = 32 * MiB, WS_WKVQ = 40 * MiB, WS_WOB = 48 * MiB, WS_WUP1 = 50 * MiB, WS_WDN1 = 58 * MiB;
constexpr size_t SLAB = (size_t)M * DM * 2;
constexpr size_t WS_SLAB0 = 66 * MiB;
constexpr size_t WS_END = WS_SLAB0 + 6 * SLAB;
static_assert(SLAB == 65 * MiB && WS_END <= 512 * MiB, "workspace map");
constexpr size_t WS_FKP = 460 * MiB, WS_CEND = 462 * MiB;
constexpr int CW_BAR = 4096, CW_ATT = 64;

constexpr int RING_BYTES = 131072;
constexpr int TAB_OFF = RING_BYTES;
constexpr int LDS_BYTES = 147456;
constexpr int MISC_OFF = LDS_BYTES - 256;

#define GAS __attribute__((address_space(1)))
#define LAS __attribute__((address_space(3)))
typedef unsigned short bf16;
typedef unsigned v4u __attribute__((ext_vector_type(4)));
typedef unsigned v2u __attribute__((ext_vector_type(2)));
typedef float f32x4 __attribute__((ext_vector_type(4)));
typedef float f32x16 __attribute__((ext_vector_type(16)));
typedef short bf16x8 __attribute__((ext_vector_type(8)));
typedef short s16x4 __attribute__((ext_vector_type(4)));
typedef GAS unsigned gu32;
#define RLX_AGENT __ATOMIC_RELAXED, __HIP_MEMORY_SCOPE_AGENT
#define LDS_WAIT() asm volatile("s_waitcnt lgkmcnt(0)" ::: "memory")
#define VM_WAIT() asm volatile("s_waitcnt vmcnt(0)" ::: "memory")

typedef float f32x2_c __attribute__((ext_vector_type(2))); typedef __bf16 bf16x2_c __attribute__((ext_vector_type(2)));
__device__ __forceinline__ unsigned pk_bf16(float lo, float hi) { const f32x2_c v = {lo, hi}; return __builtin_bit_cast(unsigned, __builtin_convertvector(v, bf16x2_c)); }
__device__ __forceinline__ float bf_lo(unsigned u) { return __uint_as_float(u << 16); }
__device__ __forceinline__ float bf_hi(unsigned u) { return __uint_as_float(u & 0xffff0000u); }
__device__ __forceinline__ float bf2f(unsigned short u) { return __uint_as_float((unsigned)u << 16); }
__device__ __forceinline__ float sigmoidf_(float z) { return __builtin_amdgcn_rcpf(1.0f + __expf(-z)); }
__device__ __forceinline__ int crow(int r, int hi) { return (r & 3) + 8 * (r >> 2) + 4 * hi; }
__device__ __forceinline__ float wave_sum(float v) {
#pragma unroll
    for (int o = 1; o < 64; o <<= 1) v += __shfl_xor(v, o);
    return v;
}
namespace pg8 {
#define PG8_LAS __attribute__((address_space(3)))
typedef unsigned short bf16_t;
typedef short bf16x8 __attribute__((ext_vector_type(8)));
typedef float f32x4 __attribute__((ext_vector_type(4)));
typedef unsigned u32x4 __attribute__((ext_vector_type(4)));
constexpr int BM = 256, BK = 64, HALF = 128, HTB = HALF * BK * 2  , STAGE_BYTES = 8 * HTB, NXCD = 8, WGM = 8;

__host__ __device__ __forceinline__ int lds_byte(int r, int c) { const int st = (r >> 4) * 2 + (c >> 5), rr = r & 15, cc = c & 31, ob = rr * 64 + cc * 2; return st * 1024 + (ob ^ (((ob >> 9) & 1) << 5)); }
__host__ __device__ __forceinline__ void stage_rc(int b, int& R, int& C) { const int st = b / 1024, sb = b % 1024, swz = sb ^ (((sb >> 9) & 1) << 5); R = (st >> 1) * 16 + swz / 64; C = (st & 1) * 32 + (swz % 64) / 2; }
__host__ __device__ __forceinline__ int perm32(int rho) { const int n = rho >> 4, i = rho & 15; return 8 * (i >> 2) + 4 * n + (i & 3); }

struct Unit { int pm, pn; };
struct Gemm { const bf16_t* A; const bf16_t* Bt; int M, N, K; };

struct StaticOrder {
    int nM, nN, nwg, G, c;
    __host__ __device__ void init(int M, int N, int G_, int c_) { nM = M / BM; nN = N / BM; nwg = nM * nN; G = G_; c = c_; }
    __host__ __device__ bool next(int i, Unit& u) const {
        const long L = (long)i * G + c; if (L >= nwg) return false;
        int wgid = (int)L; { const int q = nwg / NXCD, r = nwg % NXCD, xcd = wgid % NXCD, off = wgid / NXCD; wgid = (xcd < r ? xcd * (q + 1) : r * (q + 1) + (xcd - r) * q) + off; }
        const int nig = WGM * nN, gid = wgid / nig, fm = gid * WGM, gsz = (nM - fm) < WGM ? (nM - fm) : WGM;
        u.pm = fm + ((wgid % nig) % gsz); u.pn = (wgid % nig) / gsz; return true;
    }
    __device__ __forceinline__ void a_ready(const Unit&) const {}
    __device__ __forceinline__ void done(const Unit&) const {}
};


constexpr size_t SLAB_ELEMS = (size_t)33280 * 1024;
__device__ __forceinline__ unsigned cvt_pk_bf16(float lo, float hi) { return pk_bf16(lo, hi); }
__device__ __forceinline__ float sigm(float z) { return __builtin_amdgcn_rcpf(1.0f + __expf(-z)); }
__device__ __forceinline__ void rs_from_full(PG8_LAS float* tab, const float* rss, int pm) {
    const int tid = threadIdx.x; if (tid < 256) tab[tid] = rsqrtf(rss[pm * 256 + tid] * (1.0f / 1024.0f) + 1e-6f);
}
__device__ __forceinline__ void rs_from_parts(PG8_LAS float* tab, const float* rss16, int pm) {
    const int tid = threadIdx.x, row = tid >> 1, hf = tid & 1;
    const f32x4* p = (const f32x4*)(rss16 + (size_t)(pm * 256 + row) * 16 + hf * 8); const f32x4 a = p[0], b = p[1];
    float s = ((a.x + a.y) + (a.z + a.w)) + ((b.x + b.y) + (b.z + b.w)); s += __shfl_xor(s, 1);
    if (!hf) tab[row] = rsqrtf(s * (1.0f / 1024.0f) + 1e-6f);
}
#define PG8_PACK8(v0, v1) ((u32x4){cvt_pk_bf16((v0)[0], (v0)[1]), cvt_pk_bf16((v0)[2], (v0)[3]), cvt_pk_bf16((v1)[0], (v1)[1]), cvt_pk_bf16((v1)[2], (v1)[3])})

struct EpiIn {
    static constexpr bool PERM = true, AFTER_DRAIN = false;
    const float* rss; const float* lb; bf16_t* slab1;
    __device__ __forceinline__ void prep(PG8_LAS float* tab, const Unit& u) const { rs_from_full(tab, rss, u.pm); }
    __device__ __forceinline__ void operator()(const f32x4 (&acc)[2][2][4][2], const Unit& u, int wr, int wc, int fr, int fq, const PG8_LAS float* rst) const {
        const int seg = u.pn >> 2, colt = (u.pn & 3) * BM + wc * 32 + 8 * fq;
        const int row0 = u.pm * BM + wr * 64 + fr;
        if (seg == 1) {
            f32x4 lbv[2][2];
#pragma unroll
            for (int bj = 0; bj < 2; ++bj)
#pragma unroll
                for (int n = 0; n < 2; ++n) lbv[bj][n] = *(const f32x4*)(lb + colt + bj * HALF + 4 * n);
            char* okk = (char*)(slab1 + SLAB_ELEMS + (size_t)(u.pm * BM) * 1024); char* olf = (char*)(slab1 + 2 * SLAB_ELEMS + (size_t)(u.pm * BM) * 1024);
            const unsigned lo0 = (unsigned)((wr * 64 + fr) * 1024 + colt) * 2u;
#pragma unroll
            for (int ai = 0; ai < 2; ++ai)
#pragma unroll
                for (int m = 0; m < 4; ++m) { const float rs = rst[ai * HALF + wr * 64 + m * 16 + fr]; const unsigned ro = lo0 + (unsigned)((ai * HALF + m * 16) * 2048);
#pragma unroll
                    for (int bj = 0; bj < 2; ++bj) { f32x4 kk[2], lf[2];
#pragma unroll
                        for (int n = 0; n < 2; ++n)
#pragma unroll
                            for (int j = 0; j < 4; ++j) { const float z = acc[ai][bj][m][n][j] * rs, l = lbv[bj][n][j], sg = sigm(z), om = 1.0f - l;
                                kk[n][j] = om * (1.0f - sg); lf[n][j] = __logf(l + om * sg); }
                        *(u32x4*)(okk + (ro + bj * 256u)) = PG8_PACK8(kk[0], kk[1]); *(u32x4*)(olf + (ro + bj * 256u)) = PG8_PACK8(lf[0], lf[1]); } }
        } else {
            char* o = (char*)(slab1 + (size_t)(seg == 0 ? 0 : seg == 2 ? 3 : 4) * SLAB_ELEMS + (size_t)(u.pm * BM) * 1024);
            const unsigned lo0 = (unsigned)((wr * 64 + fr) * 1024 + colt) * 2u;
#pragma unroll
            for (int ai = 0; ai < 2; ++ai)
#pragma unroll
                for (int m = 0; m < 4; ++m) { const float rs = rst[ai * HALF + wr * 64 + m * 16 + fr]; const unsigned ro = lo0 + (unsigned)((ai * HALF + m * 16) * 2048);
#pragma unroll
                    for (int bj = 0; bj < 2; ++bj) { f32x4 v[2];
#pragma unroll
                        for (int n = 0; n < 2; ++n)
#pragma unroll
                            for (int j = 0; j < 4; ++j) { const float z = acc[ai][bj][m][n][j] * rs; v[n][j] = seg == 2 ? z : (seg == 0 ? z * sigm(z) : sigm(z)); }
                        *(u32x4*)(o + (ro + bj * 256u)) = PG8_PACK8(v[0], v[1]); } }
        }
    }
};
struct EpiRes {
    static constexpr bool PERM = true, AFTER_DRAIN = false;
    bf16_t* XB; float* rss_out;
    __device__ __forceinline__ void prep(PG8_LAS float*, const Unit&) const {}
    __device__ __forceinline__ void operator()(const f32x4 (&acc)[2][2][4][2], const Unit& u, int wr, int wc, int fr, int fq, const PG8_LAS float*) const {
        const int row0 = u.pm * BM + wr * 64 + fr, col0 = u.pn * BM + wc * 32 + 8 * fq;
        char* xbase = (char*)(XB + (size_t)(u.pm * BM) * 1024); const unsigned lo0 = (unsigned)((wr * 64 + fr) * 1024 + col0) * 2u;
#pragma unroll
        for (int ai = 0; ai < 2; ++ai)
#pragma unroll
            for (int m = 0; m < 4; ++m) { const int row = row0 + ai * HALF + m * 16; bf16_t* rowp = (bf16_t*)(xbase + (lo0 + (unsigned)((ai * HALF + m * 16) * 2048))); float s = 0.f;
#pragma unroll
                for (int bj = 0; bj < 2; ++bj) { const u32x4 old = *(const u32x4*)(rowp + bj * HALF); f32x4 v0 = acc[ai][bj][m][0], v1 = acc[ai][bj][m][1];
                    v0[0] += __uint_as_float(old.x << 16); v0[1] += __uint_as_float(old.x & 0xffff0000u); v0[2] += __uint_as_float(old.y << 16); v0[3] += __uint_as_float(old.y & 0xffff0000u);
                    v1[0] += __uint_as_float(old.z << 16); v1[1] += __uint_as_float(old.z & 0xffff0000u); v1[2] += __uint_as_float(old.w << 16); v1[3] += __uint_as_float(old.w & 0xffff0000u);
                    s += (v0[0] * v0[0] + v0[1] * v0[1]) + (v0[2] * v0[2] + v0[3] * v0[3]) + (v1[0] * v1[0] + v1[1] * v1[1]) + (v1[2] * v1[2] + v1[3] * v1[3]);
                    *(u32x4*)(rowp + bj * HALF) = PG8_PACK8(v0, v1); }
                s += __shfl_xor(s, 16); s += __shfl_xor(s, 32);
                if (fq == 0) rss_out[(size_t)row * 16 + u.pn * 4 + wc] = s; }
    }
};
struct EpiUp {
    static constexpr bool PERM = true, AFTER_DRAIN = false;
    const float* rss16; bf16_t* H;
    __device__ __forceinline__ void prep(PG8_LAS float* tab, const Unit& u) const { rs_from_parts(tab, rss16, u.pm); }
    __device__ __forceinline__ void operator()(const f32x4 (&acc)[2][2][4][2], const Unit& u, int wr, int wc, int fr, int fq, const PG8_LAS float* rst) const {
        const int row0 = u.pm * BM + wr * 64 + fr, col0 = u.pn * BM + wc * 32 + 8 * fq;
#pragma unroll
        for (int ai = 0; ai < 2; ++ai)
#pragma unroll
            for (int m = 0; m < 4; ++m) { const float rs = rst[ai * HALF + wr * 64 + m * 16 + fr]; bf16_t* rowp = (bf16_t*)((char*)(H + (size_t)(u.pm * BM) * 4096) + ((unsigned)((wr * 64 + fr) * 4096 + col0) * 2u + (unsigned)((ai * HALF + m * 16) * 8192)));
#pragma unroll
                for (int bj = 0; bj < 2; ++bj) { f32x4 v[2];
#pragma unroll
                    for (int n = 0; n < 2; ++n)
#pragma unroll
                        for (int j = 0; j < 4; ++j) { const float z = fmaxf(acc[ai][bj][m][n][j] * rs, 0.f); v[n][j] = z * z; }
                    *(u32x4*)(rowp + bj * HALF) = PG8_PACK8(v[0], v[1]); } }
    }
};
struct EpiKvq {
    static constexpr bool PERM = true, AFTER_DRAIN = false;
    const float* rss16; bf16_t* slab1; float* out; float qscale;
    __device__ __forceinline__ void prep(PG8_LAS float* tab, const Unit& u) const { rs_from_parts(tab, rss16, u.pm); }
    __device__ __forceinline__ void operator()(const f32x4 (&acc)[2][2][4][2], const Unit& u, int wr, int wc, int fr, int fq, const PG8_LAS float* rst) const {
        const int seg = u.pn >> 2, colt = (u.pn & 3) * BM + wc * 32 + 8 * fq;
        const int row0 = u.pm * BM + wr * 64 + fr;
        char* o = (char*)(slab1 + (size_t)seg * SLAB_ELEMS + (size_t)(u.pm * BM) * 1024); const unsigned lo0 = (unsigned)((wr * 64 + fr) * 1024 + colt) * 2u;
#pragma unroll
        for (int ai = 0; ai < 2; ++ai)
#pragma unroll
            for (int m = 0; m < 4; ++m) { const float rs = rst[ai * HALF + wr * 64 + m * 16 + fr]; const unsigned ro = lo0 + (unsigned)((ai * HALF + m * 16) * 2048);
#pragma unroll
                for (int bj = 0; bj < 2; ++bj) { f32x4 v[2];
#pragma unroll
                    for (int n = 0; n < 2; ++n)
#pragma unroll
                        for (int j = 0; j < 4; ++j) { const float z = acc[ai][bj][m][n][j] * rs; v[n][j] = seg == 2 ? z * qscale : (seg == 3 ? sigm(z) : z); }
                    *(u32x4*)(o + (ro + bj * 256u)) = PG8_PACK8(v[0], v[1]); } }
    }
};

template <class Epi, class Sched, bool ALIGN_EPI = false, bool SP2 = false>
__device__ __forceinline__ void gemm_phase(PG8_LAS unsigned char* lds, PG8_LAS float* tabs, const Gemm g, const Sched& S, const Epi& E) {
    const int tid = threadIdx.x, wid = __builtin_amdgcn_readfirstlane(tid >> 6), lane = tid & 63, wr = wid >> 2, wc = wid & 3, fr = lane & 15, fq = lane >> 4;
    const int K = g.K, nt = K / BK;
    unsigned voffA[2], voffB[2];
#pragma unroll
    for (int i = 0; i < 2; ++i) { int R, C; stage_rc(tid * 16 + i * 8192, R, C); const int Rb = Epi::PERM ? ((R & ~31) + perm32(R & 31)) : R;
        voffA[i] = (unsigned)(R * K + C) * 2u; voffB[i] = (unsigned)(Rb * K + C) * 2u; }
    const size_t kstep = (size_t)(BK * 2);
    const size_t hstep = (size_t)HALF * K * 2;
    const size_t tstep = 2 * hstep;
    const unsigned ldsw = (unsigned)wid * 1024u;
    const int aoff = lds_byte(wr * 64 + fr, fq * 8), boff = lds_byte(wc * 32 + fr, fq * 8);
#define PG8_SA(b, h) (((b) * 2 + (h)) * HTB)
#define PG8_SB(b, h) ((4 + (b) * 2 + (h)) * HTB)
#define PG8_STAGE(bufoff, gbase, voff) do { _Pragma("unroll") for (int _i = 0; _i < 2; ++_i) \
        __builtin_amdgcn_global_load_lds((const unsigned*)((const char*)(gbase) + (voff)[_i]), (PG8_LAS unsigned*)(lds + (bufoff) + ldsw + _i * 8192), 16, 0, 0); } while (0)
#define PG8_LDA(dst, b, h) do { _Pragma("unroll") for (int m = 0; m < 4; ++m) _Pragma("unroll") for (int k = 0; k < 2; ++k) dst[m][k] = *(const PG8_LAS bf16x8*)(lds + PG8_SA(b, h) + aoff + m * 2048 + k * 1024); } while (0)
#define PG8_LDB(dst, b, h) do { _Pragma("unroll") for (int n = 0; n < 2; ++n) _Pragma("unroll") for (int k = 0; k < 2; ++k) dst[n][k] = *(const PG8_LAS bf16x8*)(lds + PG8_SB(b, h) + boff + n * 2048 + k * 1024); } while (0)
#define PG8_MMA(ai, bj, At, Bt) do { __builtin_amdgcn_s_setprio(1); _Pragma("unroll") for (int m = 0; m < 4; ++m) _Pragma("unroll") for (int n = 0; n < 2; ++n) _Pragma("unroll") for (int k = 0; k < 2; ++k) \
        acc[ai][bj][m][n] = __builtin_amdgcn_mfma_f32_16x16x32_bf16(Bt[n][k], At[m][k], acc[ai][bj][m][n], 0, 0, 0); __builtin_amdgcn_s_setprio(0); } while (0)
#define PG8_WAIT_V(n) asm volatile("s_waitcnt vmcnt(" #n ")" ::: "memory")
#define PG8_WAIT_L(n) asm volatile("s_waitcnt lgkmcnt(" #n ")" ::: "memory")
#define PG8_BAR __builtin_amdgcn_s_barrier()
#define PG8_SCHED __builtin_amdgcn_sched_barrier(0)
    Unit cur, nxt; int ui = 0;
    if (!S.next(0, cur)) return;
    f32x4 acc[2][2][4][2];
#pragma unroll
    for (int a = 0; a < 2; ++a)
#pragma unroll
        for (int b = 0; b < 2; ++b)
#pragma unroll
            for (int m = 0; m < 4; ++m)
#pragma unroll
                for (int n = 0; n < 2; ++n) acc[a][b][m][n] = (f32x4){0.f, 0.f, 0.f, 0.f};
    bf16x8 At[4][2], B0[2][2], B1[2][2];
    const char* cA = (const char*)g.A + (size_t)cur.pm * tstep; const char* cB = (const char*)g.Bt + (size_t)cur.pn * tstep;
    S.a_ready(cur);
    { Unit pu; for (int i = 0; i < 8 && S.next(i, pu); ++i) E.prep(tabs + (i << 8), pu); }
    if constexpr (SP2) {
        PG8_STAGE(PG8_SB(0, 0), cB, voffB); PG8_STAGE(PG8_SB(0, 1), cB + hstep, voffB); PG8_STAGE(PG8_SA(0, 0), cA, voffA); PG8_STAGE(PG8_SA(0, 1), cA + hstep, voffA);
        if (wr == 1) PG8_BAR;
        PG8_WAIT_V(2); PG8_BAR;
        PG8_STAGE(PG8_SB(1, 0), cB + kstep, voffB); PG8_STAGE(PG8_SA(1, 0), cA + kstep, voffA); PG8_STAGE(PG8_SB(1, 1), cB + hstep + kstep, voffB);
        PG8_WAIT_V(6); PG8_BAR;
    } else {
        PG8_STAGE(PG8_SB(0, 0), cB, voffB); PG8_STAGE(PG8_SA(0, 0), cA, voffA); PG8_STAGE(PG8_SB(0, 1), cB + hstep, voffB); PG8_STAGE(PG8_SA(0, 1), cA + hstep, voffA);
        if (wr == 1) PG8_BAR;
        PG8_WAIT_V(4); PG8_BAR;
        PG8_STAGE(PG8_SB(1, 0), cB + kstep, voffB); PG8_STAGE(PG8_SA(1, 0), cA + kstep, voffA); PG8_STAGE(PG8_SB(1, 1), cB + hstep + kstep, voffB);
        PG8_WAIT_V(6); PG8_BAR;
    }
    for (;;) {
        const bool has_next = S.next(ui + 1, nxt);
        const char* nA = has_next ? (const char*)g.A + (size_t)nxt.pm * tstep : cA; const char* nB = has_next ? (const char*)g.Bt + (size_t)nxt.pn * tstep : cB;
        for (int t = 0; t < nt; t += 2) {
            const bool last = (t == nt - 2);
            const char* a1 = cA + (size_t)(t + 1) * kstep;
            const char* a2 = last ? nA : cA + (size_t)(t + 2) * kstep; const char* b2 = last ? nB : cB + (size_t)(t + 2) * kstep;
            const char* a3 = a2 + kstep; const char* b3 = b2 + kstep;
            if (last && has_next) S.a_ready(nxt);
            if constexpr (SP2) {
            PG8_LDB(B0, 0, 0); PG8_LDB(B1, 0, 1); PG8_SCHED; PG8_LDA(At, 0, 0); PG8_STAGE(PG8_SA(1, 1), a1 + hstep, voffA);
            PG8_WAIT_V(8); PG8_WAIT_L(0); PG8_BAR; PG8_MMA(0, 0, At, B0); PG8_MMA(0, 1, At, B1); PG8_BAR; PG8_SCHED;
            PG8_LDA(At, 0, 1); PG8_STAGE(PG8_SB(0, 0), b2, voffB); PG8_STAGE(PG8_SB(0, 1), b2 + hstep, voffB); PG8_STAGE(PG8_SA(0, 0), a2, voffA);
            PG8_WAIT_V(8); PG8_WAIT_L(0); PG8_BAR; PG8_MMA(1, 0, At, B0); PG8_MMA(1, 1, At, B1); PG8_BAR; PG8_SCHED;
            PG8_LDB(B0, 1, 0); PG8_LDB(B1, 1, 1); PG8_SCHED; PG8_LDA(At, 1, 0); PG8_STAGE(PG8_SA(0, 1), a2 + hstep, voffA);
            PG8_WAIT_V(8); PG8_WAIT_L(0); PG8_BAR; PG8_MMA(0, 0, At, B0); PG8_MMA(0, 1, At, B1); PG8_BAR; PG8_SCHED;
            PG8_LDA(At, 1, 1); PG8_STAGE(PG8_SB(1, 0), b3, voffB); PG8_STAGE(PG8_SB(1, 1), b3 + hstep, voffB); PG8_STAGE(PG8_SA(1, 0), a3, voffA);
            PG8_WAIT_V(8); PG8_WAIT_L(0); PG8_BAR; PG8_MMA(1, 0, At, B0); PG8_MMA(1, 1, At, B1); PG8_BAR; PG8_SCHED;
            } else {
            PG8_LDB(B0, 0, 0); PG8_SCHED; PG8_LDA(At, 0, 0); PG8_STAGE(PG8_SA(1, 1), a1 + hstep, voffA);
            PG8_WAIT_L(8); PG8_BAR; PG8_WAIT_L(0); PG8_MMA(0, 0, At, B0); PG8_BAR; PG8_SCHED;
            PG8_LDB(B1, 0, 1); PG8_STAGE(PG8_SB(0, 0), b2, voffB);
            PG8_BAR; PG8_WAIT_L(0); PG8_MMA(0, 1, At, B1); PG8_BAR;
            PG8_LDA(At, 0, 1); PG8_STAGE(PG8_SA(0, 0), a2, voffA);
            PG8_BAR; PG8_WAIT_L(0); PG8_MMA(1, 0, At, B0); PG8_BAR; PG8_SCHED;
            PG8_STAGE(PG8_SB(0, 1), b2 + hstep, voffB);
            PG8_WAIT_V(6); PG8_BAR; PG8_MMA(1, 1, At, B1); PG8_BAR;
            PG8_LDB(B0, 1, 0); PG8_SCHED; PG8_LDA(At, 1, 0); PG8_STAGE(PG8_SA(0, 1), a2 + hstep, voffA);
            PG8_WAIT_L(8); PG8_BAR; PG8_WAIT_L(0); PG8_MMA(0, 0, At, B0); PG8_BAR; PG8_SCHED;
            PG8_LDB(B1, 1, 1); PG8_STAGE(PG8_SB(1, 0), b3, voffB);
            PG8_BAR; PG8_WAIT_L(0); PG8_MMA(0, 1, At, B1); PG8_BAR;
            PG8_LDA(At, 1, 1); PG8_STAGE(PG8_SA(1, 0), a3, voffA);
            PG8_BAR; PG8_WAIT_L(0); PG8_MMA(1, 0, At, B0); PG8_BAR; PG8_SCHED;
            PG8_STAGE(PG8_SB(1, 1), b3 + hstep, voffB);
            PG8_WAIT_V(6); PG8_BAR; PG8_MMA(1, 1, At, B1); PG8_BAR;
            }
        }
        if constexpr (ALIGN_EPI) { if (wr == 0) PG8_BAR; }
        if constexpr (!Epi::AFTER_DRAIN) { E(acc, cur, wr, wc, fr, fq, tabs + (ui << 8)); S.done(cur); }
        if (!has_next) break;
#pragma unroll
        for (int a = 0; a < 2; ++a)
#pragma unroll
            for (int b = 0; b < 2; ++b)
#pragma unroll
                for (int m = 0; m < 4; ++m)
#pragma unroll
                    for (int n = 0; n < 2; ++n) acc[a][b][m][n] = (f32x4){0.f, 0.f, 0.f, 0.f};
        cur = nxt; cA = nA; cB = nB; ++ui;
        if constexpr (ALIGN_EPI) { if (wr == 1) PG8_BAR; }
    }
    PG8_WAIT_V(0);
    if constexpr (!ALIGN_EPI) { if (wr == 0) PG8_BAR; }
    PG8_BAR;
    if constexpr (Epi::AFTER_DRAIN) { E.fused(acc, cur, wr, wc, fr, fq, lds, wid, lane); S.done(cur); }
#undef PG8_SA
#undef PG8_SB
#undef PG8_STAGE
#undef PG8_LDA
#undef PG8_LDB
#undef PG8_MMA
#undef PG8_WAIT_V
#undef PG8_WAIT_L
#undef PG8_BAR
#undef PG8_SCHED
}
}
#define XB_TMO      128
#define XB_XCNT(j)  (256  + 64 * (j))
#define XB_XSUB(j)  (1280 + 64 * (j))
#define XB_XGEN(j)  (2304 + 64 * (j))
#define XB_TOP      3328
#define XB_TOPGEN   3392
#define XCD_BAR_WORDS 3456
#define XB_SPIN_CAP (1u << 18)

__device__ __forceinline__ unsigned xb_ld(unsigned* p)              { return __hip_atomic_load(p, __ATOMIC_RELAXED, __HIP_MEMORY_SCOPE_AGENT); }
__device__ __forceinline__ unsigned xb_add(unsigned* p, unsigned v) { return __hip_atomic_fetch_add(p, v, __ATOMIC_RELAXED, __HIP_MEMORY_SCOPE_AGENT); }
__device__ __forceinline__ unsigned xb_xcc_id() { return (unsigned)__builtin_amdgcn_s_getreg((3 << 11) | 20) & 0xFu; }
#define XB_SPIN(cond, bar) do { unsigned _sp = 0; while (cond) { __builtin_amdgcn_s_sleep(1); \
    if ((++_sp & 255u) == 0u) { if (xb_ld(&(bar)[XB_TMO])) break; if (_sp > XB_SPIN_CAP) { atomicAdd(&(bar)[XB_TMO], 1u); break; } } } } while (0)

struct XcdBarrier {
    unsigned* bar; unsigned x;
    volatile LAS unsigned* st;
};

__device__ __forceinline__ XcdBarrier xcd_barrier_post(unsigned* bar, volatile LAS unsigned* st) {
    XcdBarrier b; b.bar = bar; b.x = xb_xcc_id(); b.st = st;
    if (threadIdx.x == 0) (void)xb_add(&bar[XB_XCNT(b.x)], 1u);
    return b;
}
__device__ __forceinline__ void xcd_barrier_complete(unsigned* bar, unsigned x, unsigned& nloc, unsigned& nx) {
    const unsigned G = gridDim.x * gridDim.y * gridDim.z;
    unsigned sum, cnt, mine, sp = 0u;
    for (;;) {
        sum = 0u; cnt = 0u; mine = 0u;
#pragma unroll
        for (unsigned j = 0; j < 16; ++j) { const unsigned c = xb_ld(&bar[XB_XCNT(j)]); sum += c; cnt += (c > 0u) ? 1u : 0u; mine = (j == x) ? c : mine; }
        if (sum == G) break;
        __builtin_amdgcn_s_sleep(1);
        if ((++sp & 255u) == 0u) { if (xb_ld(&bar[XB_TMO])) break; if (sp > XB_SPIN_CAP) { atomicAdd(&bar[XB_TMO], 1u); break; } }
    }
    nloc = mine > 0u ? mine : 1u; nx = cnt > 0u ? cnt : 1u;
}

__device__ __forceinline__ void xcd_barrier(const XcdBarrier& b) {
    asm volatile("s_waitcnt vmcnt(0)" ::: "memory");
    __syncthreads();
    if (threadIdx.x == 0) {
        unsigned* bar = b.bar;
        __builtin_amdgcn_s_waitcnt(0);
        unsigned nloc = b.st[0], nx = b.st[1];
        if (nloc == 0u) { xcd_barrier_complete(bar, b.x, nloc, nx); b.st[0] = nloc; b.st[1] = nx; }
        const unsigned old = xb_add(&bar[XB_XSUB(b.x)], 1u);
        const unsigned gen = old / nloc;
        if (old + 1u == (gen + 1u) * nloc) {
            __builtin_amdgcn_fence(__ATOMIC_RELEASE, "agent");
            asm volatile("s_waitcnt vmcnt(0)" ::: "memory");
            const unsigned og = xb_add(&bar[XB_TOP], 1u);
            const unsigned tg = og / nx;
            if (og + 1u == (tg + 1u) * nx) xb_add(&bar[XB_TOPGEN], 1u);
            else XB_SPIN(xb_ld(&bar[XB_TOPGEN]) == tg, bar);
            __builtin_amdgcn_fence(__ATOMIC_ACQUIRE, "agent");
            xb_add(&bar[XB_XGEN(b.x)], 1u);
            asm volatile("s_waitcnt vmcnt(0)" ::: "memory");
        } else {
            XB_SPIN(xb_ld(&bar[XB_XGEN(b.x)]) == gen, bar);
            __builtin_amdgcn_fence(__ATOMIC_ACQUIRE, "agent");
            asm volatile("s_waitcnt vmcnt(0)" ::: "memory");
        }
    }
    __syncthreads();
}

namespace gla {
constexpr int L_QD = 0, L_KI = 16384, L_KE = 32768, L_VV = 49152, L_OT = 65536, OT_PITCH = 528, L_XCH = 65536, L_QTOT = 99328, L_DK = 103424, L_SS = 103936, L_END = 104960;
static_assert(L_OT + 64 * OT_PITCH <= L_QTOT && L_XCH + 32768 <= L_QTOT && L_END <= RING_BYTES, "gla LDS map");
__device__ __forceinline__ s16x4 vtr(const LAS unsigned char* p) { typedef short v4i16_t __attribute__((ext_vector_type(4))); return __builtin_bit_cast(s16x4, __builtin_amdgcn_ds_read_tr16_b64_v4i16((LAS v4i16_t*)p)); }
#define GLA_MFMA(a, b, c) __builtin_amdgcn_mfma_f32_32x32x16_bf16(a, b, c, 0, 0, 0)
__device__ __forceinline__ void unit(LAS unsigned char* lds, const bf16* Q, bf16* Oout, int omask, const bf16* KK, const bf16* LF, const bf16* I, const bf16* G, const float* gnorm,
                                     int row0, int nchunks, int h, const float* s0, float* sfin) {
    const int tid = threadIdx.x, lane = tid & 63, r = lane & 31, hi = lane >> 5; const int w = __builtin_amdgcn_readfirstlane(tid >> 6);
    const int vt = w & 3, hf = w >> 2;
    f32x16 S[4];
#pragma unroll
    for (int kt = 0; kt < 4; ++kt)
#pragma unroll
        for (int g = 0; g < 16; ++g) S[kt][g] = s0 ? s0[(size_t)(32 * kt + crow(g, hi)) * 128 + 32 * vt + r] : 0.f;
    float gn8[8];
#pragma unroll
    for (int j = 0; j < 8; ++j) gn8[j] = gnorm[8 * (tid & 15) + j];
    LAS float* qtot = (LAS float*)(lds + L_QTOT); LAS float* dk = (LAS float*)(lds + L_DK); LAS float* ssl = (LAS float*)(lds + L_SS);
    unsigned lfr[8], qvr[8], kvr[8]; v4u vxr[2];
#define GLA_LOAD(nn) do { const int mm_ = row0 + 64 * (nn); const size_t go_ = (size_t)(mm_ + 8 * w) * DM + h * 128 + 2 * lane; \
        _Pragma("unroll") for (int i = 0; i < 8; ++i) { lfr[i] = *(const unsigned*)(LF + go_ + (size_t)i * DM); qvr[i] = *(const unsigned*)(Q + go_ + (size_t)i * DM); kvr[i] = *(const unsigned*)(KK + go_ + (size_t)i * DM); } \
        _Pragma("unroll") for (int j = 0; j < 2; ++j) { const int p_ = tid + 512 * j; vxr[j] = *(const v4u*)(I + (size_t)(mm_ + (p_ >> 4)) * DM + h * 128 + 8 * (p_ & 15)); } } while (0)
    GLA_LOAD(0);
    for (int n = 0; n < nchunks; ++n) {
        const int m0 = row0 + 64 * n;
        int tid_ = threadIdx.x; asm volatile("" : "+v"(tid_));
        const int tid = tid_, lane = tid & 63, r = lane & 31, hi = lane >> 5;
        {
            float c0[8], c1[8]; float run0 = 0.f, run1 = 0.f;
#pragma unroll
            for (int i = 0; i < 8; ++i) { run0 += bf_lo(lfr[i]); run1 += bf_hi(lfr[i]); c0[i] = run0; c1[i] = run1; }
            typedef float f32x2_t __attribute__((ext_vector_type(2)));
            LAS f32x2_t* qtot2 = (LAS f32x2_t*)qtot;
            qtot2[w * 64 + lane] = (f32x2_t){run0, run1};
#pragma unroll
            for (int j = 0; j < 2; ++j) { const int p = tid + 512 * j, s = p >> 4, v8 = p & 15;
                *(LAS v4u*)(lds + L_VV + (v8 >> 2) * 4096 + s * 64 + (v8 & 3) * 16) = vxr[j]; }
            __syncthreads();
            float pre0 = 0.f, pre1 = 0.f, bt0 = 0.f, bt1 = 0.f;
#pragma unroll
            for (int ww = 0; ww < 8; ++ww) { const f32x2_t t_ = qtot2[ww * 64 + lane]; bt0 += t_[0]; bt1 += t_[1]; if (ww < w) { pre0 += t_[0]; pre1 += t_[1]; } }
            const float eb0 = __expf(bt0), eb1 = __expf(bt1);
#pragma unroll
            for (int i = 0; i < 8; ++i) { const int t = 8 * w + i; const float e0 = __expf(pre0 + c0[i]), e1 = __expf(pre1 + c1[i]);
                const float ki0 = bf_lo(kvr[i]) * __builtin_amdgcn_rcpf(e0), ki1 = bf_hi(kvr[i]) * __builtin_amdgcn_rcpf(e1);
                const int ro = t * 256 + ((((lane >> 2) ^ (t & 15))) << 4) + (lane & 3) * 4;
                *(LAS unsigned*)(lds + L_QD + ro) = pk_bf16(bf_lo(qvr[i]) * e0, bf_hi(qvr[i]) * e1);
                *(LAS unsigned*)(lds + L_KI + ro) = pk_bf16(ki0, ki1);
                *(LAS unsigned*)(lds + L_KE + (lane >> 4) * 4096 + t * 64 + (lane & 15) * 4) = pk_bf16(ki0 * eb0, ki1 * eb1); }
            if (w == 0) { dk[2 * lane] = eb0; dk[2 * lane + 1] = eb1; }
            if (n + 1 < nchunks) GLA_LOAD(n + 1);
            __syncthreads();
        }
        v4u ggr[2];
#pragma unroll
        for (int j = 0; j < 2; ++j) { const int p = tid + 512 * j; ggr[j] = *(const v4u*)(G + (size_t)(m0 + (p >> 4)) * DM + h * 128 + 8 * (p & 15)); }
        f32x16 o;
#pragma unroll
        for (int g = 0; g < 16; ++g) o[g] = 0.f;
        {
            const int row = 32 * hf + r;
#pragma unroll
            for (int kt = 0; kt < 4; ++kt)
#pragma unroll
                for (int ksl = 0; ksl < 2; ++ksl) {
                    const int chunk = 4 * kt + 2 * ksl;
                    const v2u b0 = *(const LAS v2u*)(lds + L_QD + row * 256 + (((chunk) ^ (row & 15)) << 4) + 8 * hi);
                    const v2u b1 = *(const LAS v2u*)(lds + L_QD + row * 256 + (((chunk + 1) ^ (row & 15)) << 4) + 8 * hi);
                    const v4u bq = (v4u){b0.x, b0.y, b1.x, b1.y};
                    const v4u aq = (v4u){pk_bf16(S[kt][8 * ksl + 0], S[kt][8 * ksl + 1]), pk_bf16(S[kt][8 * ksl + 2], S[kt][8 * ksl + 3]),
                                         pk_bf16(S[kt][8 * ksl + 4], S[kt][8 * ksl + 5]), pk_bf16(S[kt][8 * ksl + 6], S[kt][8 * ksl + 7])};
                    o = GLA_MFMA(__builtin_bit_cast(bf16x8, aq), __builtin_bit_cast(bf16x8, bq), o);
                }
        }
        bf16x8 vf[4];
        {
            const LAS unsigned char* vb = lds + L_VV + vt * 4096 + ((lane >> 4) & 1) * 32 + (lane & 3) * 8 + (4 * hi + ((lane & 15) >> 2)) * 64;
#pragma unroll
            for (int ks = 0; ks < 4; ++ks) { const s16x4 lo = vtr(vb + ks * 1024), hh = vtr(vb + ks * 1024 + 512); vf[ks] = (bf16x8){lo[0], lo[1], lo[2], lo[3], hh[0], hh[1], hh[2], hh[3]}; }
        }
        for (int st = 0; st <= hf; ++st) {
            f32x16 X;
#pragma unroll
            for (int g = 0; g < 16; ++g) X[g] = 0.f;
            const int rs_ = 32 * st + r, rt_ = 32 * hf + r;
#pragma unroll
            for (int k8 = 0; k8 < 8; ++k8) {
                const bf16x8 a = *(const LAS bf16x8*)(lds + L_KI + rs_ * 256 + (((2 * k8 + hi) ^ (rs_ & 15)) << 4));
                const bf16x8 b = *(const LAS bf16x8*)(lds + L_QD + rt_ * 256 + (((2 * k8 + hi) ^ (rt_ & 15)) << 4));
                X = GLA_MFMA(a, b, X);
            }
            if (st == hf) {
#pragma unroll
                for (int g = 0; g < 16; ++g) if (crow(g, hi) > r) X[g] = 0.f;
            }
            const v4u x0 = (v4u){pk_bf16(X[0], X[1]), pk_bf16(X[2], X[3]), pk_bf16(X[4], X[5]), pk_bf16(X[6], X[7])};
            const v4u x1 = (v4u){pk_bf16(X[8], X[9]), pk_bf16(X[10], X[11]), pk_bf16(X[12], X[13]), pk_bf16(X[14], X[15])};
            if (st == 0) { o = GLA_MFMA(vf[0], __builtin_bit_cast(bf16x8, x0), o); o = GLA_MFMA(vf[1], __builtin_bit_cast(bf16x8, x1), o); }
            else         { o = GLA_MFMA(vf[2], __builtin_bit_cast(bf16x8, x0), o); o = GLA_MFMA(vf[3], __builtin_bit_cast(bf16x8, x1), o); }
        }
#pragma unroll
        for (int kt = 0; kt < 4; ++kt) {
#pragma unroll
            for (int j = 0; j < 4; ++j) { const f32x4 d4 = *(const LAS f32x4*)(dk + 32 * kt + 8 * j + 4 * hi);
                S[kt][4 * j + 0] *= d4[0]; S[kt][4 * j + 1] *= d4[1]; S[kt][4 * j + 2] *= d4[2]; S[kt][4 * j + 3] *= d4[3]; }
            const LAS unsigned char* kb = lds + L_KE + kt * 4096 + ((lane >> 4) & 1) * 32 + (lane & 3) * 8 + (4 * hi + ((lane & 15) >> 2)) * 64;
#pragma unroll
            for (int ks = 0; ks < 4; ++ks) { const s16x4 lo = vtr(kb + ks * 1024), hh = vtr(kb + ks * 1024 + 512);
                const bf16x8 a = (bf16x8){lo[0], lo[1], lo[2], lo[3], hh[0], hh[1], hh[2], hh[3]};
                S[kt] = GLA_MFMA(a, vf[ks], S[kt]); }
        }
        {
            float ssq = 0.f;
#pragma unroll
            for (int g = 0; g < 16; ++g) ssq += o[g] * o[g];
            ssq += __shfl_xor(ssq, 32);
            const int t = 32 * hf + r;
            if (hi == 0) ssl[vt * 64 + t] = ssq;
#pragma unroll
            for (int j = 0; j < 4; ++j) *(LAS f32x4*)(lds + L_OT + t * OT_PITCH + (32 * vt + 8 * j + 4 * hi) * 4) = (f32x4){o[4 * j], o[4 * j + 1], o[4 * j + 2], o[4 * j + 3]};
        }
        __syncthreads();
#pragma unroll
        for (int j = 0; j < 2; ++j) { const int p = tid + 512 * j, t = p >> 4, c8 = p & 15;
            const float rn = rsqrtf(((ssl[t] + ssl[64 + t]) + (ssl[128 + t] + ssl[192 + t])) * (1.0f / 128.0f) + EPS);
            const f32x4 a = *(const LAS f32x4*)(lds + L_OT + t * OT_PITCH + c8 * 32), b = *(const LAS f32x4*)(lds + L_OT + t * OT_PITCH + c8 * 32 + 16);
            const v4u gg = ggr[j];
            v4u ov; ov.x = pk_bf16(a[0] * rn * gn8[0] * bf_lo(gg.x), a[1] * rn * gn8[1] * bf_hi(gg.x)); ov.y = pk_bf16(a[2] * rn * gn8[2] * bf_lo(gg.y), a[3] * rn * gn8[3] * bf_hi(gg.y));
            ov.z = pk_bf16(b[0] * rn * gn8[4] * bf_lo(gg.z), b[1] * rn * gn8[5] * bf_hi(gg.z)); ov.w = pk_bf16(b[2] * rn * gn8[6] * bf_lo(gg.w), b[3] * rn * gn8[7] * bf_hi(gg.w));
            *(v4u*)(Oout + (size_t)((m0 + t) & omask) * DM + h * 128 + 8 * c8) = ov; }
    }
    if (hf == 0) {
#pragma unroll
        for (int kt = 0; kt < 4; ++kt)
#pragma unroll
            for (int g = 0; g < 16; ++g) sfin[(size_t)(32 * kt + crow(g, hi)) * 128 + 32 * vt + r] = S[kt][g]; }
    __syncthreads();
}
#undef GLA_MFMA
#undef GLA_LOAD
}

namespace att2 {
using bf16x8=__attribute__((ext_vector_type(8)))short;
using s16x4=__attribute__((ext_vector_type(4)))short;
using f32x16=__attribute__((ext_vector_type(16)))float;
using u32x4=__attribute__((ext_vector_type(4)))unsigned;
constexpr int NHEAD=16,SEQ=2048,D=64,DM=NHEAD*D;
constexpr int NW=8,QBLK=32,QB=QBLK*NW,KVBLK=64,NQB=SEQ/QB;
constexpr int ATTN_PITCH=DM, ATTN_UNIT_ROWS=QB;
__device__ __forceinline__ int crow(int r,int hi){return (r&3)+8*(r>>2)+4*hi;}
#define SBAR() __builtin_amdgcn_sched_barrier(0)
__device__ __forceinline__ void cmask(f32x16&p0,f32x16&p1,int jb,int qrel,int hi){
  const float NEG=-__builtin_inff(); int kb=64*jb+4*hi;
  #pragma unroll
  for(int r=0;r<16;++r){int kv=kb+(r&3)+8*(r>>2); if(kv>qrel)p0[r]=NEG; if(kv+32>qrel)p1[r]=NEG;}
}

constexpr int NSLOT=3, SLOTB=8192;
constexpr int LDS_K=0, LDS_V=NSLOT*SLOTB, LDS_WS=2*NSLOT*SLOTB, LDS_OST=LDS_WS+NW*64*4, LDS_FK=LDS_OST+NW*4096, LDS_CJ=LDS_FK+8192, LDS_BYTES=LDS_CJ+256;
constexpr float C2=0.125f*1.4426950408889634f;
__device__ __forceinline__ void glds16(const void*gsrc,unsigned lds_dst){unsigned keep;
  asm volatile("s_mov_b32 %0, m0\n\ts_mov_b32 m0, %2\n\ts_nop 0\n\tglobal_load_lds_dwordx4 %1, off\n\ts_mov_b32 m0, %0":"=&s"(keep):"v"(gsrc),"s"(lds_dst):"memory");}
__device__ __forceinline__ float max3f(float a,float b,float c){float r;asm("v_max3_f32 %0, %1, %2, %3":"=v"(r):"v"(a),"v"(b),"v"(c));return r;}
__device__ __forceinline__ float max2f(float a,float b){float r;asm("v_max_f32_e32 %0, %1, %2":"=v"(r):"v"(a),"v"(b));return r;}
__device__ __forceinline__ float fadd_s(float a,float b){float r;asm("v_add_f32_e32 %0, %1, %2":"=v"(r):"v"(a),"v"(b));return r;}
__device__ __forceinline__ float fsub_s(float a,float b){float r;asm("v_sub_f32_e32 %0, %1, %2":"=v"(r):"v"(a),"v"(b));return r;}
typedef float f32x2_t __attribute__((ext_vector_type(2))); typedef __bf16 bf16x2_t __attribute__((ext_vector_type(2)));
__device__ __forceinline__ unsigned cvtpk_s(float lo,float hi){f32x2_t v={lo,hi};bf16x2_t b=__builtin_convertvector(v,bf16x2_t);return __builtin_bit_cast(unsigned,b);}
#define WAIT_BAR(N) asm volatile("s_waitcnt vmcnt(" #N ") lgkmcnt(0)\n\ts_barrier":::"memory")

__device__ __forceinline__ void qkt(f32x16&p0,f32x16&p1,const char*Kslot,const bf16x8*qr,int r32,int hi){
  const char*kb=Kslot+hi*1024+r32*16;
  #pragma unroll
  for(int d0=0;d0<4;++d0){
    const bf16x8 b0=*reinterpret_cast<const bf16x8*>(kb+d0*2048);
    const bf16x8 b1=*reinterpret_cast<const bf16x8*>(kb+d0*2048+512);
    p0=__builtin_amdgcn_mfma_f32_32x32x16_bf16(b0,qr[d0],p0,0,0,0);p1=__builtin_amdgcn_mfma_f32_32x32x16_bf16(b1,qr[d0],p1,0,0,0);}
}
typedef __attribute__((address_space(3))) const char* lds_cptr;
typedef short v4i16_t __attribute__((ext_vector_type(4)));
__device__ __forceinline__ void kload8(bf16x8*kf,lds_cptr kp){
  kf[0]=*(const __attribute__((address_space(3))) bf16x8*)(kp);      kf[1]=*(const __attribute__((address_space(3))) bf16x8*)(kp+512);
  kf[2]=*(const __attribute__((address_space(3))) bf16x8*)(kp+2048); kf[3]=*(const __attribute__((address_space(3))) bf16x8*)(kp+2560);
  kf[4]=*(const __attribute__((address_space(3))) bf16x8*)(kp+4096); kf[5]=*(const __attribute__((address_space(3))) bf16x8*)(kp+4608);
  kf[6]=*(const __attribute__((address_space(3))) bf16x8*)(kp+6144); kf[7]=*(const __attribute__((address_space(3))) bf16x8*)(kp+6656);
}
__device__ __forceinline__ void kload2(bf16x8*kf,lds_cptr kp,int j){ kf[2*j]=*(const __attribute__((address_space(3))) bf16x8*)(kp+j*2048); kf[2*j+1]=*(const __attribute__((address_space(3))) bf16x8*)(kp+j*2048+512); }
__device__ __forceinline__ s16x4 vtr(lds_cptr p){ return __builtin_bit_cast(s16x4,__builtin_amdgcn_ds_read_tr16_b64_v4i16((__attribute__((address_space(3))) v4i16_t*)p)); }
__device__ __forceinline__ float rowmax(const f32x16&p0,const f32x16&p1){
  float a=max3f(p0[0],p0[1],p1[0]),b=max3f(p0[2],p0[3],p1[1]);a=max3f(a,p1[2],p1[3]);
  #pragma unroll
  for(int r=4;r<16;r+=4){a=max3f(a,p0[r],p0[r+1]);b=max3f(b,p0[r+2],p0[r+3]);a=max3f(a,p1[r],p1[r+1]);b=max3f(b,p1[r+2],p1[r+3]);}
  const float m=max2f(a,b);
  auto rr=__builtin_amdgcn_permlane32_swap(__float_as_uint(m),__float_as_uint(m),false,false);
  return max2f(__uint_as_float(rr[0]),__uint_as_float(rr[1]));
}
__device__ __forceinline__ void pv(f32x16*o,int vb,bf16x8 pa0,bf16x8 pa1,bf16x8 pa2,bf16x8 pa3){
  #pragma unroll
  for(int d0=0;d0<2;++d0){s16x4 lo[4],hi[4];
    #pragma unroll
    for(int ks=0;ks<4;++ks){
      asm volatile("ds_read_b64_tr_b16 %0,%1 offset:%c2":"=&v"(lo[ks]):"v"(vb),"i"(d0*4096+ks*1024):"memory");
      asm volatile("ds_read_b64_tr_b16 %0,%1 offset:%c2":"=&v"(hi[ks]):"v"(vb),"i"(d0*4096+ks*1024+512):"memory");}
    asm volatile("s_waitcnt lgkmcnt(0)":::"memory");SBAR();
    #define PK(k) (bf16x8){lo[k][0],lo[k][1],lo[k][2],lo[k][3],hi[k][0],hi[k][1],hi[k][2],hi[k][3]}
    o[d0]=__builtin_amdgcn_mfma_f32_32x32x16_bf16(pa0,PK(0),o[d0],0,0,0);
    o[d0]=__builtin_amdgcn_mfma_f32_32x32x16_bf16(pa1,PK(1),o[d0],0,0,0);
    o[d0]=__builtin_amdgcn_mfma_f32_32x32x16_bf16(pa2,PK(2),o[d0],0,0,0);
    o[d0]=__builtin_amdgcn_mfma_f32_32x32x16_bf16(pa3,PK(3),o[d0],0,0,0);
    #undef PK
  }
}

#ifndef ATTN_STORE16
#define ATTN_STORE16(p,v) (*(u32x4*)(p)=(v))
#endif
template<int THRL> __device__ __forceinline__ void attn_unit(int b,int h,int qb,const bf16*Q,const bf16*__restrict__ K,const bf16*__restrict__ V,const bf16*__restrict__ G,bf16*O,const unsigned*__restrict__ FKP,const float*__restrict__ CEND,char*shm){
  int tid_=threadIdx.x; asm volatile("":"+v"(tid_));
  const int tid=tid_,lane=tid&63,r32=lane&31,hi=lane>>5; const int wid=__builtin_amdgcn_readfirstlane(tid>>6);
  const long rowbase=(long)b*SEQ; const int q0=qb*QB;
  const bf16*Qw=Q+(rowbase+q0+wid*QBLK)*DM+h*D;
  const bf16*Kh=K+rowbase*DM+h*D,*Vh=V+rowbase*DM+h*D;
  const unsigned lds0=(unsigned)(uintptr_t)shm;
  float*wsf=(float*)(shm+LDS_WS)+wid*64;
  const float*wsh=wsf+4*hi;
  const bf16*ksrc=Kh+(long)lane*DM+wid*8;
  const bf16*vsrc=Vh+(long)(16*(wid&3)+(lane>>2))*DM+(wid>>2)*32+(lane&3)*8;
  const unsigned kdst=lds0+LDS_K+wid*1024, vdst=lds0+LDS_V+wid*1024;
  #define DMA_K(t,slot) glds16(ksrc+(long)(NT-1-(t))*KVBLK*DM,(unsigned)__builtin_amdgcn_readfirstlane(kdst+(slot)))
  #define DMA_V(t,slot) glds16(vsrc+(long)(NT-1-(t))*KVBLK*DM,(unsigned)__builtin_amdgcn_readfirstlane(vdst+(slot)))
  const int vb0=(int)(lds0+LDS_V)+((lane>>4)&1)*32+(lane&3)*8+(4*hi+((lane&15)>>2))*64;
  const char*Kbase=shm+LDS_K; bf16x8 kf[8];
  const lds_cptr shm3=(lds_cptr)shm; const lds_cptr kp0=shm3+LDS_K+hi*1024+r32*16; const lds_cptr vp0=shm3+LDS_V+((lane>>4)&1)*32+(lane&3)*8+(4*hi+((lane&15)>>2))*64;
  const int NT=(q0+QB)/KVBLK;
  DMA_K(0,0);DMA_V(0,0);DMA_K(1,SLOTB);
  unsigned*fkl=(unsigned*)(shm+LDS_FK); float*cjl=(float*)(shm+LDS_CJ);
  { const float cref=CEND[NT-1]; _Pragma("unroll") for(int k_=0;k_<4;++k_){const int i=tid+k_*NW*64; if(i<NT*KVBLK)fkl[i]=FKP[i];} if(tid<NT)cjl[tid]=cref-CEND[tid]; }
  bf16x8 qr[4];
  #pragma unroll
  for(int d0=0;d0<4;++d0)qr[d0]=*reinterpret_cast<const bf16x8*>(&Qw[(long)r32*DM+d0*16+hi*8]);
  float mhat=0.f,l_reg=0.f;f32x16 o[2];o[0]=f32x16{};o[1]=f32x16{};
  const unsigned ONES=0x3f803f80u;
  unsigned fk0c=0u,fk1c=0u; float cjc=0.f;
  #define BIAS_LD(t) do{ const int tl_=NT-1-(t); fk0c=fkl[tl_*KVBLK+r32]; fk1c=fkl[tl_*KVBLK+32+r32]; cjc=cjl[tl_]; }while(0)
  #define BIAS_OPS(t) const unsigned fk0_=fk0c,fk1_=fk1c; const float cj_=cjc; \
    const float x_=cj_-mhat; const unsigned xh_=cvtpk_s(x_,0.f)&0xffffu; const float xhf_=__uint_as_float(xh_<<16); const float xl_=x_-xhf_; const unsigned xp_=xh_|(cvtpk_s(xl_,0.f)<<16); \
    mhat=cj_-(xhf_+__uint_as_float(xp_&0xffff0000u)); \
    const u32x4 kx0_={fk0_,ONES,0u,0u},kx1_={fk1_,ONES,0u,0u},qx_={hi?0u:ONES,hi?0u:xp_,0u,0u}; const f32x16 z16_=f32x16{};
  #define CMASK(P0,P1,t) do{int jb_=3-(t); if(jb_>=0)cmask(P0,P1,jb_,wid*QBLK+r32,hi);}while(0)
  bool resc=false;
  #define START(P0,P1) do{ const float rm=__builtin_fmaxf(rowmax(P0,P1),-1.0e4f); resc=false; \
    { const float dl=rm; mhat=fadd_s(mhat,dl); \
      _Pragma("unroll") for(int r=0;r<16;++r){P0[r]=fsub_s(P0[r],dl);P1[r]=fsub_s(P1[r],dl);} } \
    _Pragma("unroll") for(int r=0;r<16;++r)P0[r]=__builtin_amdgcn_exp2f(P0[r]); }while(0)
  #define RESC() do{ if(resc){ asm volatile("s_waitcnt lgkmcnt(0)":::"memory"); \
      _Pragma("unroll") for(int d_=0;d_<2;++d_) _Pragma("unroll") for(int r=0;r<16;++r)o[d_][r]*=wsh[(r&3)+8*(r>>2)]; } }while(0)
  f32x16 pA0,pA1,pB0,pB1;
  int sl_prev=0,sl_cur=0,sl_next=SLOTB;
  #define ROT() do{sl_prev=sl_cur;sl_cur=sl_next;sl_next=(sl_next==(NSLOT-1)*SLOTB)?0:sl_next+SLOTB;}while(0)
  DMA_K(2,2*SLOTB);
  WAIT_BAR(3);
  BIAS_LD(0);
  { BIAS_OPS(0); pA0=__builtin_amdgcn_mfma_f32_32x32x16_bf16(__builtin_bit_cast(bf16x8,kx0_),__builtin_bit_cast(bf16x8,qx_),z16_,0,0,0); pA1=__builtin_amdgcn_mfma_f32_32x32x16_bf16(__builtin_bit_cast(bf16x8,kx1_),__builtin_bit_cast(bf16x8,qx_),z16_,0,0,0); }
  BIAS_LD(1);
  qkt(pA0,pA1,Kbase,qr,r32,hi);asm volatile("s_nop 15\n\ts_nop 7":"+v"(pA0),"+v"(pA1));CMASK(pA0,pA1,0);
  START(pA0,pA1);
  _Pragma("unroll") for(int r=0;r<16;++r)pA1[r]=__builtin_amdgcn_exp2f(pA1[r]);
  WAIT_BAR(0);
  DMA_K(3,0);DMA_V(1,SLOTB);
  ROT();
  kload8(kf,kp0+sl_cur);
  WAIT_BAR(2);
  s16x4 vlo[8],vhi[8]; u32x4 pw0,pw1,pw2,pw3;
  #define PKW(P,B) cvtpk_s(P[B],P[B+1])
  #define PAF(k) __builtin_bit_cast(bf16x8,pw##k)
  #define VFR(i) (bf16x8){vlo[i][0],vlo[i][1],vlo[i][2],vlo[i][3],vhi[i][0],vhi[i][1],vhi[i][2],vhi[i][3]}
  #define PIN(x) asm volatile("":"+v"(x))
  #define MX3(a,b,c) __builtin_fmaxf(__builtin_fmaxf((a),(b)),(c))
  #define GAPA(MF,A0,A1,A2,A3,W0,W1,PW) do{ MF; sacc+=A0; sacc+=A1; sacc+=A2; sacc+=A3; PIN(sacc); W0; W1; PIN(PW); SBAR(); }while(0)
  #define EX(v) __builtin_amdgcn_exp2f(v)
  #define GAPB(MF,X,B) do{ MF; X[B]=EX(X[B]); X[B+1]=EX(X[B+1]); X[B+2]=EX(X[B+2]); X[B+3]=EX(X[B+3]); PIN(X); SBAR(); }while(0)
  #define VRD(i) do{ vlo[i]=vtr(vp_+(((i)>>2)*4096+((i)&3)*1024)); vhi[i]=vtr(vp_+(((i)>>2)*4096+((i)&3)*1024+512)); }while(0)
  #define KRD(G,j) do{ if(G){ kload2(kf,kp0+sl_next,j); SBAR(); } }while(0)
  #define STEP(C0,C1,P0,P1,t,GK,GV,GL) do{ SBAR(); \
    const lds_cptr vp_=vp0+sl_prev; \
    { BIAS_OPS(t) \
      C0=__builtin_amdgcn_mfma_f32_32x32x16_bf16(__builtin_bit_cast(bf16x8,kx0_),__builtin_bit_cast(bf16x8,qx_),z16_,0,0,0); \
      C1=__builtin_amdgcn_mfma_f32_32x32x16_bf16(__builtin_bit_cast(bf16x8,kx1_),__builtin_bit_cast(bf16x8,qx_),z16_,0,0,0); } SBAR(); \
    VRD(0); SBAR(); float sacc=(P0[0]+P0[1]); \
    GAPA(C0=__builtin_amdgcn_mfma_f32_32x32x16_bf16(kf[0],qr[0],C0,0,0,0), P0[2],P0[3],P0[4],P0[5],     pw0[0]=PKW(P0,0), pw0[1]=PKW(P0,2), pw0); \
    VRD(4); SBAR(); GAPA(C1=__builtin_amdgcn_mfma_f32_32x32x16_bf16(kf[1],qr[0],C1,0,0,0), P0[6],P0[7],P0[8],P0[9],     pw0[2]=PKW(P0,4), pw0[3]=PKW(P0,6), pw0); \
    VRD(1); SBAR(); GAPA(C0=__builtin_amdgcn_mfma_f32_32x32x16_bf16(kf[2],qr[1],C0,0,0,0),   P0[10],P0[11],P0[12],P0[13], pw1[0]=PKW(P0,8), pw1[1]=PKW(P0,10), pw1); \
    VRD(5); SBAR(); GAPA(C1=__builtin_amdgcn_mfma_f32_32x32x16_bf16(kf[3],qr[1],C1,0,0,0),   P0[14],P0[15],P1[0],P1[1],   pw1[2]=PKW(P0,12),pw1[3]=PKW(P0,14), pw1); \
    VRD(2); SBAR(); GAPA(C0=__builtin_amdgcn_mfma_f32_32x32x16_bf16(kf[4],qr[2],C0,0,0,0),   P1[2],P1[3],P1[4],P1[5],     pw2[0]=PKW(P1,0), pw2[1]=PKW(P1,2), pw2); \
    VRD(6); SBAR(); GAPA(C1=__builtin_amdgcn_mfma_f32_32x32x16_bf16(kf[5],qr[2],C1,0,0,0),   P1[6],P1[7],P1[8],P1[9],     pw2[2]=PKW(P1,4), pw2[3]=PKW(P1,6), pw2); \
    VRD(3); SBAR(); GAPA(C0=__builtin_amdgcn_mfma_f32_32x32x16_bf16(kf[6],qr[3],C0,0,0,0),   P1[10],P1[11],P1[12],P1[13], pw3[0]=PKW(P1,8), pw3[1]=PKW(P1,10), pw3); \
    VRD(7); SBAR(); GAPA(C1=__builtin_amdgcn_mfma_f32_32x32x16_bf16(kf[7],qr[3],C1,0,0,0),   P1[14],P1[15],0.f,0.f,       pw3[2]=PKW(P1,12),pw3[3]=PKW(P1,14), pw3); \
    l_reg+=sacc; \
    if(GK){DMA_K((t)+3,sl_cur);} if(GV){DMA_V((t)+1,sl_next);} \
    CMASK(C0,C1,t); \
    { float a=MX3(C0[0],C0[1],C1[0]),b=MX3(C0[2],C0[3],C1[1]); a=MX3(a,C1[2],C1[3]); \
      _Pragma("unroll") for(int r=4;r<16;r+=4){a=MX3(a,C0[r],C0[r+1]);b=MX3(b,C0[r+2],C0[r+3]);a=MX3(a,C1[r],C1[r+1]);b=MX3(b,C1[r+2],C1[r+3]);} \
      float rm=__builtin_fmaxf(a,b); { auto rr=__builtin_amdgcn_permlane32_swap(__float_as_uint(rm),__float_as_uint(rm),false,false); rm=__builtin_fmaxf(__uint_as_float(rr[0]),__uint_as_float(rr[1])); } \
      resc=false; \
      if(__builtin_expect(__any(rm>(float)THRL),0)){ const float dl=__builtin_fmaxf(rm,0.f); mhat+=dl; \
        _Pragma("unroll") for(int r=0;r<16;++r){C0[r]-=dl;C1[r]-=dl;} \
        const float f=__builtin_amdgcn_exp2f(-dl); l_reg*=f; if(hi==0)wsf[r32]=f; resc=true; } } \
    if(GV){BIAS_LD((t)+1);} \
    SBAR(); \
    GAPB(o[0]=__builtin_amdgcn_mfma_f32_32x32x16_bf16(PAF(0),VFR(0),o[0],0,0,0), C0,0); \
    GAPB(o[1]=__builtin_amdgcn_mfma_f32_32x32x16_bf16(PAF(0),VFR(4),o[1],0,0,0), C0,4); \
    KRD(GL,0); GAPB(o[0]=__builtin_amdgcn_mfma_f32_32x32x16_bf16(PAF(1),VFR(1),o[0],0,0,0), C0,8); \
    KRD(GL,1); GAPB(o[1]=__builtin_amdgcn_mfma_f32_32x32x16_bf16(PAF(1),VFR(5),o[1],0,0,0), C0,12); \
    KRD(GL,2); GAPB(o[0]=__builtin_amdgcn_mfma_f32_32x32x16_bf16(PAF(2),VFR(2),o[0],0,0,0), C1,0); \
    KRD(GL,3); GAPB(o[1]=__builtin_amdgcn_mfma_f32_32x32x16_bf16(PAF(2),VFR(6),o[1],0,0,0), C1,4); \
    GAPB(o[0]=__builtin_amdgcn_mfma_f32_32x32x16_bf16(PAF(3),VFR(3),o[0],0,0,0), C1,8); \
    GAPB(o[1]=__builtin_amdgcn_mfma_f32_32x32x16_bf16(PAF(3),VFR(7),o[1],0,0,0), C1,12); \
    }while(0)
  int t=1;
  #define ENDW(tt) do{ if((tt)+3<NT){WAIT_BAR(2);} else if((tt)+2<NT){WAIT_BAR(1);} else {WAIT_BAR(0);} }while(0)
  for(;t<5&&t+1<NT;t+=2){
    STEP(pB0,pB1,pA0,pA1,t,(t+3<NT),(t+1<NT),(t+1<NT));       ENDW(t);   RESC(); ROT();
    STEP(pA0,pA1,pB0,pB1,t+1,(t+4<NT),(t+2<NT),(t+2<NT));     ENDW(t+1); RESC(); ROT();
  }
  #undef CMASK
  #define CMASK(P0,P1,t) do{}while(0)
  for(;t+5<NT;t+=2){
    STEP(pB0,pB1,pA0,pA1,t,true,true,true);     WAIT_BAR(2); RESC(); ROT();
    STEP(pA0,pA1,pB0,pB1,t+1,true,true,true);   WAIT_BAR(2); RESC(); ROT();
  }
  for(;t+1<NT;t+=2){
    STEP(pB0,pB1,pA0,pA1,t,(t+3<NT),(t+1<NT),(t+1<NT));       ENDW(t);   RESC(); ROT();
    STEP(pA0,pA1,pB0,pB1,t+1,(t+4<NT),(t+2<NT),(t+2<NT));     ENDW(t+1); RESC(); ROT();
  }
  #undef CMASK
  #define CMASK(P0,P1,t) do{int jb_=3-(t); if(jb_>=0)cmask(P0,P1,jb_,wid*QBLK+r32,hi);}while(0)
  const bf16*Gw=G+(rowbase+q0+wid*QBLK)*DM+h*D; u32x4 ggp[4];
  #pragma unroll
  for(int i=0;i<4;++i)ggp[i]=*(const u32x4*)(Gw+(long)(i*8+(lane>>3))*DM+(lane&7)*8);
  STEP(pB0,pB1,pA0,pA1,NT-1,false,false,false); RESC();
  { float sacc=pB0[0]+pB0[1]; _Pragma("unroll") for(int r=2;r<16;++r)sacc+=pB0[r]; _Pragma("unroll") for(int r=0;r<16;++r)sacc+=pB1[r]; l_reg+=sacc;
    pw0=(u32x4){PKW(pB0,0),PKW(pB0,2),PKW(pB0,4),PKW(pB0,6)};pw1=(u32x4){PKW(pB0,8),PKW(pB0,10),PKW(pB0,12),PKW(pB0,14)};pw2=(u32x4){PKW(pB1,0),PKW(pB1,2),PKW(pB1,4),PKW(pB1,6)};pw3=(u32x4){PKW(pB1,8),PKW(pB1,10),PKW(pB1,12),PKW(pB1,14)};
    SBAR(); pv(o,vb0+sl_cur,PAF(0),PAF(1),PAF(2),PAF(3)); }
  #undef PKW
  #undef PAF
  #undef VFR
  #undef PIN
  #undef MX3
  #undef GAPA
  #undef GAPB
  #undef EX
  #undef VRD
  #undef KRD
  #undef STEP
  #undef ENDW
  {auto rr=__builtin_amdgcn_permlane32_swap(__float_as_uint(l_reg),__float_as_uint(l_reg),false,false);l_reg=__uint_as_float(rr[0])+__uint_as_float(rr[1]);}
  if(hi==0)wsf[32+r32]=l_reg;asm volatile("s_waitcnt lgkmcnt(0)":::"memory");
  float rli[16];
  #pragma unroll
  for(int r=0;r<16;++r)rli[r]=__builtin_amdgcn_rcpf(wsh[32+(r&3)+8*(r>>2)]);
  bf16*Ow=O+(rowbase+q0+wid*QBLK)*DM+h*D;
  { bf16*stg=(bf16*)(shm+LDS_OST)+wid*2048;
    #pragma unroll
    for(int r=0;r<16;++r){const int orow=crow(r,hi);
      #pragma unroll
      for(int d0=0;d0<2;++d0)stg[orow*64+d0*32+r32]=(unsigned short)(cvtpk_s(o[d0][r]*rli[r],0.f)&0xffffu);}
    asm volatile("s_waitcnt lgkmcnt(0)":::"memory");
    #pragma unroll
    for(int i=0;i<4;++i){const int row=i*8+(lane>>3),ch=lane&7; const u32x4 v=*(const u32x4*)(stg+row*64+ch*8); const u32x4 gg=ggp[i]; u32x4 ov;
      ov.x=cvtpk_s(__uint_as_float(v.x<<16)*__uint_as_float(gg.x<<16),__uint_as_float(v.x&0xffff0000u)*__uint_as_float(gg.x&0xffff0000u)); ov.y=cvtpk_s(__uint_as_float(v.y<<16)*__uint_as_float(gg.y<<16),__uint_as_float(v.y&0xffff0000u)*__uint_as_float(gg.y&0xffff0000u));
      ov.z=cvtpk_s(__uint_as_float(v.z<<16)*__uint_as_float(gg.z<<16),__uint_as_float(v.z&0xffff0000u)*__uint_as_float(gg.z&0xffff0000u)); ov.w=cvtpk_s(__uint_as_float(v.w<<16)*__uint_as_float(gg.w<<16),__uint_as_float(v.w&0xffff0000u)*__uint_as_float(gg.w&0xffff0000u));
      ATTN_STORE16(Ow+(long)row*DM+ch*8,ov);} }
  asm volatile("s_waitcnt lgkmcnt(0)\n\ts_barrier":::"memory");
  #undef DMA_K
  #undef DMA_V
  #undef CMASK
  #undef START
  #undef RESC
  #undef ROT
  #undef BIAS_OPS
  #undef BIAS_LD
}
constexpr int ATTN_LDS_BYTES=LDS_BYTES;
#undef SBAR
#undef WAIT_BAR
}

namespace att3 {
constexpr int L_SCR = RING_BYTES;
__device__ __forceinline__ s16x4 vtr(const LAS unsigned char* p) { typedef short v4i16_t __attribute__((ext_vector_type(4))); return __builtin_bit_cast(s16x4, __builtin_amdgcn_ds_read_tr16_b64_v4i16((LAS v4i16_t*)p)); }
__device__ __forceinline__ void glds16(const void* gsrc, unsigned lds_dst) { unsigned keep;
    asm volatile("s_mov_b32 %0, m0\n\ts_mov_b32 m0, %2\n\ts_nop 0\n\tglobal_load_lds_dwordx4 %1, off\n\ts_mov_b32 m0, %0" : "=&s"(keep) : "v"(gsrc), "s"(lds_dst) : "memory"); }
#define A3_MFMA(a, b, c) __builtin_amdgcn_mfma_f32_32x32x16_bf16(a, b, c, 0, 0, 0)
__device__ __forceinline__ void unit(LAS unsigned char* lds, unsigned lds0, const bf16* Qrows, const bf16* Grows, bf16* Orows, const float* Kc, const float* Vc, const bf16* Kn, const bf16* Vn, const float* F) {
    int tid_ = threadIdx.x; asm volatile("" : "+v"(tid_));
    const int tid = tid_, lane = tid & 63, r = lane & 31, hi = lane >> 5; const int w = __builtin_amdgcn_readfirstlane(tid >> 6);
    LAS unsigned char* buf = lds + w * 16384; const unsigned bufa = lds0 + (unsigned)w * 16384u;
    LAS float* scr = (LAS float*)(lds + L_SCR + w * 512);
    const float fref = F[(size_t)PAST * 16];
    bf16x8 qr[2][4];
#pragma unroll
    for (int qb = 0; qb < 2; ++qb)
#pragma unroll
        for (int d0 = 0; d0 < 4; ++d0) qr[qb][d0] = *(const bf16x8*)(Qrows + (size_t)(32 * qb + r) * DM + d0 * 16 + hi * 8);
    f32x16 o[2][2]; float mrun[2], lrun[2];
#pragma unroll
    for (int qb = 0; qb < 2; ++qb) { mrun[qb] = -1e30f; lrun[qb] = 0.f;
#pragma unroll
        for (int g = 0; g < 16; ++g) { o[qb][0][g] = 0.f; o[qb][1][g] = 0.f; } }
    const int vrow = lane >> 2, vcol = 8 * (lane & 3);
    for (int j = w; j <= PAST / 64; j += 8) {
        const bool isnew = j == PAST / 64;
        if (isnew) {
            const bf16* kp_ = Kn + (size_t)lane * DM; unsigned kd_ = bufa;
#pragma unroll 1
            for (int c = 0; c < 8; ++c) { glds16(kp_, (unsigned)__builtin_amdgcn_readfirstlane(kd_)); kp_ += 8; kd_ += 1024; }
            const bf16* vp_ = Vn + (size_t)vrow * DM + vcol;
#pragma unroll 1
            for (int pr = 0; pr < 4; ++pr) { glds16(vp_, (unsigned)__builtin_amdgcn_readfirstlane(kd_)); glds16(vp_ + 32, (unsigned)__builtin_amdgcn_readfirstlane(kd_ + 4096)); vp_ += (size_t)16 * DM; kd_ += 1024; }
        } else {
            const int rr = lane >> 2, q4 = lane & 3;
            const float* kf = Kc + ((size_t)64 * j + rr) * DM + 4 * q4; const float* vf_ = Vc + ((size_t)64 * j + rr) * DM + 4 * q4;
#pragma unroll
            for (int ih = 0; ih < 2; ++ih) {
                f32x4 kr[8], vr[8];
#pragma unroll
                for (int i2 = 0; i2 < 2; ++i2)
#pragma unroll
                    for (int jq = 0; jq < 4; ++jq) { const int i = 2 * ih + i2; kr[4 * i2 + jq] = *(const f32x4*)(kf + (size_t)16 * i * DM + 16 * jq); vr[4 * i2 + jq] = *(const f32x4*)(vf_ + (size_t)16 * i * DM + 16 * jq); }
#pragma unroll
                for (int i2 = 0; i2 < 2; ++i2)
#pragma unroll
                    for (int jq = 0; jq < 4; ++jq) { const f32x4 k4 = kr[4 * i2 + jq], v4 = vr[4 * i2 + jq]; const int row = 16 * (2 * ih + i2) + rr;
                        *(LAS v2u*)(buf + (2 * jq + (q4 >> 1)) * 1024 + row * 16 + (q4 & 1) * 8) = (v2u){pk_bf16(k4[0], k4[1]), pk_bf16(k4[2], k4[3])};
                        *(LAS v2u*)(buf + 8192 + (jq >> 1) * 4096 + row * 64 + (jq & 1) * 32 + q4 * 8) = (v2u){pk_bf16(v4[0], v4[1]), pk_bf16(v4[2], v4[3])}; }
            }
        }
        const float fkv = (fref - F[((size_t)64 * j + lane) * 16]) * LOG2E;
        scr[lane] = fkv;
        asm volatile("s_waitcnt vmcnt(0) lgkmcnt(0)" ::: "memory");
        __builtin_amdgcn_sched_barrier(0);
        bf16x8 ka[4], kb[4];
#pragma unroll
        for (int d0 = 0; d0 < 4; ++d0) { ka[d0] = *(const LAS bf16x8*)(buf + hi * 1024 + r * 16 + d0 * 2048); kb[d0] = *(const LAS bf16x8*)(buf + hi * 1024 + r * 16 + d0 * 2048 + 512); }
        const LAS unsigned char* vb = buf + 8192 + ((lane >> 4) & 1) * 32 + (lane & 3) * 8 + (4 * hi + ((lane & 15) >> 2)) * 64;
#pragma unroll
        for (int qb = 0; qb < 2; ++qb) {
            f32x16 p0, p1;
#pragma unroll
            for (int jj = 0; jj < 4; ++jj) { const f32x4 f0 = *(const LAS f32x4*)(scr + 8 * jj + 4 * hi), f1 = *(const LAS f32x4*)(scr + 32 + 8 * jj + 4 * hi);
#pragma unroll
                for (int i = 0; i < 4; ++i) { p0[4 * jj + i] = f0[i]; p1[4 * jj + i] = f1[i]; } }
#pragma unroll
            for (int d0 = 0; d0 < 4; ++d0) { p0 = A3_MFMA(ka[d0], qr[qb][d0], p0); p1 = A3_MFMA(kb[d0], qr[qb][d0], p1); }
            if (isnew) { const int qrel = 32 * qb + r;
#pragma unroll
                for (int g = 0; g < 16; ++g) { const int kv = crow(g, hi); if (kv > qrel) p0[g] = -__builtin_inff(); if (kv + 32 > qrel) p1[g] = -__builtin_inff(); } }
            float rm = fmaxf(p0[0], p1[0]);
#pragma unroll
            for (int g = 1; g < 16; ++g) rm = fmaxf(rm, fmaxf(p0[g], p1[g]));
            rm = fmaxf(rm, __shfl_xor(rm, 32));
            const float mnew = fmaxf(mrun[qb], rm), alpha = __builtin_amdgcn_exp2f(mrun[qb] - mnew); mrun[qb] = mnew;
            float ps = 0.f;
#pragma unroll
            for (int g = 0; g < 16; ++g) { p0[g] = __builtin_amdgcn_exp2f(p0[g] - mnew); p1[g] = __builtin_amdgcn_exp2f(p1[g] - mnew); ps += p0[g] + p1[g]; }
            lrun[qb] = lrun[qb] * alpha + ps;
            if (hi == 0) scr[64 + r] = alpha;
#pragma unroll
            for (int jj = 0; jj < 4; ++jj) { const f32x4 a4 = *(const LAS f32x4*)(scr + 64 + 8 * jj + 4 * hi);
#pragma unroll
                for (int i = 0; i < 4; ++i) { o[qb][0][4 * jj + i] *= a4[i]; o[qb][1][4 * jj + i] *= a4[i]; } }
            const v4u pw0 = (v4u){pk_bf16(p0[0], p0[1]), pk_bf16(p0[2], p0[3]), pk_bf16(p0[4], p0[5]), pk_bf16(p0[6], p0[7])};
            const v4u pw1 = (v4u){pk_bf16(p0[8], p0[9]), pk_bf16(p0[10], p0[11]), pk_bf16(p0[12], p0[13]), pk_bf16(p0[14], p0[15])};
            const v4u pw2 = (v4u){pk_bf16(p1[0], p1[1]), pk_bf16(p1[2], p1[3]), pk_bf16(p1[4], p1[5]), pk_bf16(p1[6], p1[7])};
            const v4u pw3 = (v4u){pk_bf16(p1[8], p1[9]), pk_bf16(p1[10], p1[11]), pk_bf16(p1[12], p1[13]), pk_bf16(p1[14], p1[15])};
#pragma unroll
            for (int d0 = 0; d0 < 2; ++d0) {
                bf16x8 vf[4];
#pragma unroll
                for (int ks = 0; ks < 4; ++ks) { const s16x4 lo = vtr(vb + d0 * 4096 + ks * 1024), hh = vtr(vb + d0 * 4096 + ks * 1024 + 512);
                    vf[ks] = (bf16x8){lo[0], lo[1], lo[2], lo[3], hh[0], hh[1], hh[2], hh[3]}; }
                o[qb][d0] = A3_MFMA(__builtin_bit_cast(bf16x8, pw0), vf[0], o[qb][d0]); o[qb][d0] = A3_MFMA(__builtin_bit_cast(bf16x8, pw1), vf[1], o[qb][d0]);
                o[qb][d0] = A3_MFMA(__builtin_bit_cast(bf16x8, pw2), vf[2], o[qb][d0]); o[qb][d0] = A3_MFMA(__builtin_bit_cast(bf16x8, pw3), vf[3], o[qb][d0]);
            }
        }
        asm volatile("s_waitcnt lgkmcnt(0)" ::: "memory");
        __builtin_amdgcn_sched_barrier(0);
    }
#pragma unroll
    for (int qb = 0; qb < 2; ++qb) {
        lrun[qb] += __shfl_xor(lrun[qb], 32);
#pragma unroll
        for (int g = 0; g < 16; ++g)
#pragma unroll
            for (int d0 = 0; d0 < 2; ++d0) *(LAS float*)(buf + (32 * qb + crow(g, hi)) * 256 + (32 * d0 + r) * 4) = o[qb][d0][g];
        if (hi == 0) { scr[32 * qb + r] = mrun[qb]; scr[64 + 32 * qb + r] = lrun[qb]; }
    }
    __syncthreads();
    {
        const int row = tid >> 3, dg = tid & 7; float mw[8], M_ = -1e30f;
#pragma unroll
        for (int ww = 0; ww < 8; ++ww) { mw[ww] = *(const LAS float*)(lds + L_SCR + ww * 512 + row * 4); M_ = fmaxf(M_, mw[ww]); }
        float Lsum = 0.f; f32x4 a0 = (f32x4){0.f, 0.f, 0.f, 0.f}, a1 = a0;
#pragma unroll
        for (int ww = 0; ww < 8; ++ww) { const float sc = __builtin_amdgcn_exp2f(mw[ww] - M_); Lsum += sc * *(const LAS float*)(lds + L_SCR + ww * 512 + 256 + row * 4);
            const f32x4 x0 = *(const LAS f32x4*)(lds + ww * 16384 + row * 256 + dg * 32), x1 = *(const LAS f32x4*)(lds + ww * 16384 + row * 256 + dg * 32 + 16);
            a0 += x0 * sc; a1 += x1 * sc; }
        const float rl = __builtin_amdgcn_rcpf(Lsum); const size_t go = (size_t)row * DM + 8 * dg; const v4u gg = *(const v4u*)(Grows + go);
        v4u ov; ov.x = pk_bf16(a0[0] * rl * bf_lo(gg.x), a0[1] * rl * bf_hi(gg.x)); ov.y = pk_bf16(a0[2] * rl * bf_lo(gg.y), a0[3] * rl * bf_hi(gg.y));
        ov.z = pk_bf16(a1[0] * rl * bf_lo(gg.z), a1[1] * rl * bf_hi(gg.z)); ov.w = pk_bf16(a1[2] * rl * bf_lo(gg.w), a1[3] * rl * bf_hi(gg.w));
        *(v4u*)(Orows + go) = ov;
    }
    __syncthreads();
}
#undef A3_MFMA
}

namespace sg {
enum { IN = 0, RES = 1, UP = 2, KVQ = 3 };
struct P {
    const bf16* A; const bf16* Bt; int K, N;
    const float* rss; int rss_parts;
    const float* lb;
    bf16* o0; float* rss_out; float* out;
};
constexpr int SG_STAGE = 24576, SG_NS = 4, SG_RED = SG_NS * SG_STAGE;
__device__ __forceinline__ void glds16(const void* gsrc, unsigned lds_dst) { unsigned keep;
    asm volatile("s_mov_b32 %0, m0\n\ts_mov_b32 m0, %2\n\ts_nop 0\n\tglobal_load_lds_dwordx4 %1, off\n\ts_mov_b32 m0, %0" : "=&s"(keep) : "v"(gsrc), "s"(lds_dst) : "memory"); }
template <int MODE> __device__ __forceinline__ void phase(LAS unsigned char* lds, unsigned lds0, const P& p, int vcu, int G) {
    const int tid = threadIdx.x, lane = tid & 63, r = lane & 31, hi = lane >> 5; const int w = __builtin_amdgcn_readfirstlane(tid >> 6);
    const int nh = w & 1, kq = w >> 1, nct = p.N >> 6, nblk = p.K >> 7, ntile = 16 * nct;
    LAS float* red = (LAS float*)(lds + SG_RED);
    if (vcu >= ntile) return;
    const int mytiles = (ntile - vcu + G - 1) / G, NB = mytiles * nblk;
    const int lr = lane >> 4, sl = lane & 15;
    const int arow = 4 * w + lr, brow0 = 4 * w + lr, brow1 = 32 + 4 * w + lr;
    const int acol = ((sl ^ (arow & 15)) << 3), bcol0 = ((sl ^ (brow0 & 15)) << 3), bcol1 = ((sl ^ (brow1 & 15)) << 3);
#define SG_DMA(n_) do { const int ti_ = (n_) / nblk, bk_ = (n_) - ti_ * nblk, tt_ = vcu + ti_ * G, rt_ = tt_ & 15, ct_ = tt_ >> 4; const unsigned st_ = lds0 + (unsigned)(((n_) & (SG_NS - 1)) * SG_STAGE); \
        glds16(p.A + (size_t)(MP + 32 * rt_ + arow) * p.K + bk_ * 128 + acol, (unsigned)__builtin_amdgcn_readfirstlane(st_ + w * 1024)); \
        glds16(p.Bt + (size_t)(64 * ct_ + brow0) * p.K + bk_ * 128 + bcol0, (unsigned)__builtin_amdgcn_readfirstlane(st_ + 8192 + w * 1024)); \
        glds16(p.Bt + (size_t)(64 * ct_ + brow1) * p.K + bk_ * 128 + bcol1, (unsigned)__builtin_amdgcn_readfirstlane(st_ + 16384 + w * 1024)); } while (0)
    SG_DMA(0); if (NB > 1) SG_DMA(1); if (NB > 2) SG_DMA(2);
    f32x16 acc;
#pragma unroll
    for (int g = 0; g < 16; ++g) acc[g] = 0.f;
    const int fa0 = r * 256 + (((4 * kq + hi) ^ (r & 15)) << 4), fa1 = r * 256 + (((4 * kq + 2 + hi) ^ (r & 15)) << 4);
    int n = 0, t = vcu;
    for (;;) {
        const int rt = t & 15, ct = t >> 4, row0 = MP + 32 * rt, col0 = 64 * ct;
        const int g0 = 2 * w, rowA = row0 + crow(g0, hi), rowB = row0 + crow(g0 + 1, hi), c0 = col0 + r, c1 = c0 + 32;
        float ssA = 0.f, ssB = 0.f; f32x4 pa[4], pb[4]; unsigned short xo[4];
        {
            if (MODE == RES) { const bf16* xa = p.o0 + (size_t)rowA * 1024; const bf16* xb = p.o0 + (size_t)rowB * 1024; xo[0] = xa[c0]; xo[1] = xa[c1]; xo[2] = xb[c0]; xo[3] = xb[c1]; }
            else if (p.rss_parts == 1) { ssA = p.rss[rowA]; ssB = p.rss[rowB]; }
            else { const f32x4* qa = (const f32x4*)(p.rss + (size_t)rowA * 16); const f32x4* qb = (const f32x4*)(p.rss + (size_t)rowB * 16);
#pragma unroll
                for (int q = 0; q < 4; ++q) { pa[q] = qa[q]; pb[q] = qb[q]; } }
        }
        for (int bk = 0; bk < nblk; ++bk, ++n) {
            if (n + 2 < NB) asm volatile("s_waitcnt vmcnt(6) lgkmcnt(0)\n\ts_barrier" ::: "memory");
            else if (n + 1 < NB) asm volatile("s_waitcnt vmcnt(3) lgkmcnt(0)\n\ts_barrier" ::: "memory");
            else asm volatile("s_waitcnt vmcnt(0) lgkmcnt(0)\n\ts_barrier" ::: "memory");
            if (n + 3 < NB) SG_DMA(n + 3);
            const LAS unsigned char* st = lds + (n & (SG_NS - 1)) * SG_STAGE;
            const bf16x8 a0 = *(const LAS bf16x8*)(st + fa0), a1 = *(const LAS bf16x8*)(st + fa1);
            const bf16x8 b0 = *(const LAS bf16x8*)(st + 8192 + nh * 8192 + fa0), b1 = *(const LAS bf16x8*)(st + 8192 + nh * 8192 + fa1);
            acc = __builtin_amdgcn_mfma_f32_32x32x16_bf16(a0, b0, acc, 0, 0, 0);
            acc = __builtin_amdgcn_mfma_f32_32x32x16_bf16(a1, b1, acc, 0, 0, 0);
        }
#pragma unroll
        for (int g = 0; g < 16; ++g) { red[(w * 16 + g) * 64 + lane] = acc[g]; acc[g] = 0.f; }
        asm volatile("s_waitcnt lgkmcnt(0)\n\ts_barrier" ::: "memory");
#pragma unroll
        for (int gi = 0; gi < 2; ++gi) {
            const int g = g0 + gi; float v0 = 0.f, v1 = 0.f;
#pragma unroll
            for (int q = 0; q < 4; ++q) { v0 += red[((2 * q) * 16 + g) * 64 + lane]; v1 += red[((2 * q + 1) * 16 + g) * 64 + lane]; }
            const int row = gi ? rowB : rowA;
            float rs = 1.f;
            if (MODE != RES) {
                float ss;
                if (p.rss_parts == 1) ss = gi ? ssB : ssA;
                else { const f32x4 a0 = gi ? pb[0] : pa[0], a1 = gi ? pb[1] : pa[1], a2 = gi ? pb[2] : pa[2], a3 = gi ? pb[3] : pa[3];
                    ss = (((a0[0] + a0[1]) + (a0[2] + a0[3])) + ((a1[0] + a1[1]) + (a1[2] + a1[3]))) + (((a2[0] + a2[1]) + (a2[2] + a2[3])) + ((a3[0] + a3[1]) + (a3[2] + a3[3]))); }
                rs = rsqrtf(ss * (1.0f / 1024.0f) + EPS);
            }
            const float z0 = v0 * rs, z1 = v1 * rs;
#define SG_ST(ptr, val) *(ptr) = (unsigned short)(pk_bf16((val), 0.f) & 0xffffu)
            if (MODE == IN) {
                const int seg = col0 >> 10, cc0 = c0 & 1023, cc1 = c1 & 1023; const size_t ro = (size_t)row * 1024;
                if (seg == 1) { const float l0 = p.lb[cc0], l1 = p.lb[cc1], s0 = sigmoidf_(z0), s1 = sigmoidf_(z1);
                    SG_ST(p.o0 + pg8::SLAB_ELEMS + ro + cc0, (1.f - l0) * (1.f - s0)); SG_ST(p.o0 + pg8::SLAB_ELEMS + ro + cc1, (1.f - l1) * (1.f - s1));
                    SG_ST(p.o0 + 2 * pg8::SLAB_ELEMS + ro + cc0, __logf(l0 + (1.f - l0) * s0)); SG_ST(p.o0 + 2 * pg8::SLAB_ELEMS + ro + cc1, __logf(l1 + (1.f - l1) * s1)); }
                else { bf16* o = p.o0 + (size_t)(seg == 0 ? 0 : seg == 2 ? 3 : 4) * pg8::SLAB_ELEMS + ro;
                    SG_ST(o + cc0, seg == 2 ? z0 : (seg == 0 ? z0 * sigmoidf_(z0) : sigmoidf_(z0))); SG_ST(o + cc1, seg == 2 ? z1 : (seg == 0 ? z1 * sigmoidf_(z1) : sigmoidf_(z1))); }
            } else if (MODE == RES) {
                bf16* xp = p.o0 + (size_t)row * 1024; const float x0 = bf2f(xo[2 * gi]) + v0, x1 = bf2f(xo[2 * gi + 1]) + v1;
                SG_ST(xp + c0, x0); SG_ST(xp + c1, x1);
                float sq = x0 * x0 + x1 * x1; sq += __shfl_xor(sq, 1); sq += __shfl_xor(sq, 2); sq += __shfl_xor(sq, 4); sq += __shfl_xor(sq, 8); sq += __shfl_xor(sq, 16);
                if (r == 0) p.rss_out[(size_t)row * 16 + ct] = sq;
            } else if (MODE == UP) {
                bf16* o = p.o0 + (size_t)row * 4096; const float h0 = fmaxf(z0, 0.f), h1 = fmaxf(z1, 0.f);
                SG_ST(o + c0, h0 * h0); SG_ST(o + c1, h1 * h1);
            } else {
                const int seg = col0 >> 10, cc0 = c0 & 1023, cc1 = c1 & 1023; const size_t ro = (size_t)row * 1024;
                bf16* o = p.o0 + (size_t)seg * pg8::SLAB_ELEMS + ro;
                if (seg < 2) { SG_ST(o + cc0, z0); SG_ST(o + cc1, z1); float* fo = p.out + (seg == 0 ? OK_S : OV_S) + (size_t)(row - MP) * 1024; fo[cc0] = z0; fo[cc1] = z1; }
                else if (seg == 2) { SG_ST(o + cc0, z0 * QSCALE); SG_ST(o + cc1, z1 * QSCALE); }
                else { SG_ST(o + cc0, sigmoidf_(z0)); SG_ST(o + cc1, sigmoidf_(z1)); }
            }
#undef SG_ST
        }
        asm volatile("s_waitcnt lgkmcnt(0)\n\ts_barrier" ::: "memory");
        t += G; if (t >= ntile) break;
    }
    __syncthreads();
#undef SG_DMA
}
}

constexpr int NWAVES = 8;
#ifndef MK_N_LAUNCHES
#define MK_N_LAUNCHES 1
#endif
constexpr int N_PHASES = 13;
constexpr int N_LAUNCHES = MK_N_LAUNCHES;

struct Args {
    const float* in[21]; float* out_; unsigned char* ws_; int ph_lo, ph_hi, dry_gla, pad;
};

__device__ __forceinline__ void p0_transpose_item(const float* W, int K, int ldw, int nblk, const float* gain, bf16* WT, int row_off, LAS float* scr, int item, int lane) {
    const int kb = item / nblk, nb = item % nblk, k0 = 64 * kb, n0 = 32 * nb;
    {
        const int rg = lane >> 3, c4 = lane & 7; f32x4 v[8]; float gs[8];
#pragma unroll
        for (int i = 0; i < 8; ++i) { const int kk = 8 * i + rg; v[i] = *(const f32x4*)(W + (size_t)(k0 + kk) * ldw + n0 + 4 * c4); gs[i] = gain ? gain[k0 + kk] : 1.0f; }
#pragma unroll
        for (int i = 0; i < 8; ++i) { const int kk = 8 * i + rg; LAS float* d = scr + kk * 33 + 4 * c4; d[0] = v[i][0] * gs[i]; d[1] = v[i][1] * gs[i]; d[2] = v[i][2] * gs[i]; d[3] = v[i][3] * gs[i]; }
    }
    LDS_WAIT(); asm volatile("" ::: "memory");
    const int c = lane & 7;
#pragma unroll
    for (int j = 0; j < 4; ++j) { const int n = (lane >> 3) + 8 * j; const LAS float* s = scr + (8 * c) * 33 + n;
        v4u o; o.x = pk_bf16(s[0 * 33], s[1 * 33]); o.y = pk_bf16(s[2 * 33], s[3 * 33]); o.z = pk_bf16(s[4 * 33], s[5 * 33]); o.w = pk_bf16(s[6 * 33], s[7 * 33]);
        *(v4u*)(WT + (size_t)(row_off + n0 + n) * K + k0 + 8 * c) = o; }
    LDS_WAIT(); asm volatile("" ::: "memory");
}

__global__ void __launch_bounds__(NWAVES * 64, 2) yoco_fwd(Args args) {
    extern __shared__ __attribute__((aligned(16))) unsigned char lds_raw[];
    LAS unsigned char* lds = (LAS unsigned char*)lds_raw;
    volatile LAS unsigned* MISC = (volatile LAS unsigned*)(lds + MISC_OFF);
    const int tid = threadIdx.x, lane = tid & 63; const int wave = __builtin_amdgcn_readfirstlane(tid >> 6);
    const int G = gridDim.x, bx = blockIdx.x;
    const int vcu = (G % 8 == 0) ? (bx % 8) * (G / 8) + bx / 8 : bx;
    const int gw = vcu * NWAVES + wave, NGW = G * NWAVES;
#define ws (args.ws_)
#define out (args.out_)
#define ctl ((gu32*)(args.ws_ + WS_CTL))
#define lbv ((float*)(ws + WS_LB))
#define Wlf_t ((bf16*)(ws + WS_WLF))
#define rssx ((float*)(ws + WS_RSSX))
#define rssA ((float*)(ws + WS_RSSA))
#define rssB ((float*)(ws + WS_RSSB))
#define Fs ((float*)(ws + WS_FS))
#define Win_t ((bf16*)(ws + WS_WIN))
#define Wo_t ((bf16*)(ws + WS_WO))
#define Wup0_t ((bf16*)(ws + WS_WUP0))
#define Wdn0_t ((bf16*)(ws + WS_WDN0))
#define Wkvq_t ((bf16*)(ws + WS_WKVQ))
#define Wob_t ((bf16*)(ws + WS_WOB))
#define Wup1_t ((bf16*)(ws + WS_WUP1))
#define Wdn1_t ((bf16*)(ws + WS_WDN1))
#define XB ((bf16*)(ws + WS_SLAB0))
#define S1 ((bf16*)(ws + WS_SLAB0 + SLAB))
#define S2 ((bf16*)(ws + WS_SLAB0 + 2 * SLAB))
#define S3 ((bf16*)(ws + WS_SLAB0 + 3 * SLAB))
#define S4 ((bf16*)(ws + WS_SLAB0 + 4 * SLAB))
#define S5 ((bf16*)(ws + WS_SLAB0 + 5 * SLAB))
    LAS float* tabs = (LAS float*)(lds + TAB_OFF);

    for (int u = tid; u < 64; u += NWAVES * 64) ((LAS unsigned*)(lds + MISC_OFF))[u] = 0u;
    __syncthreads();
    XcdBarrier bar; bar.bar = (unsigned*)(ctl + CW_BAR); bar.x = 0; bar.st = nullptr;
    if (N_LAUNCHES == 1) bar = xcd_barrier_post((unsigned*)(ctl + CW_BAR), MISC + 8);
#define GRID_BAR() do { if (N_LAUNCHES == 1) xcd_barrier(bar); } while (0)
    const int lo = args.ph_lo, hi_ph = args.ph_hi;
#ifndef PHASE_MASK
#define PHASE_MASK 0x1fff
#endif
#define IN(k) (((PHASE_MASK >> (k)) & 1) && lo <= (k) && (k) < hi_ph)
#define SEAM(k) do { if (IN(k) && IN((k) + 1)) GRID_BAR(); } while (0)

    if (IN(0)) {
        LAS float* scr = (LAS float*)(lds + wave * 16384);
        constexpr int I_IN = 16 * 128, I_O = 16 * 32;
        for (int it = gw; it < I_IN + I_O; it += NGW) {
            if (it < I_IN) p0_transpose_item(args.in[7], 1024, 4096, 128, args.in[6], Win_t, 0, scr, it, lane);
            else p0_transpose_item(args.in[10], 1024, 1024, 32, nullptr, Wo_t, 0, scr, it - I_IN, lane);
        }
        const int gt = gw * 64 + lane, NGT = NGW * 64;
        for (int c = gt; c < 1024; c += NGT) lbv[c] = 1.0f / (1.0f + __expf(args.in[8][1024 + c] - args.in[8][c]));
        for (int m0 = gw; m0 < M; m0 += 4 * NGW) {
            f32x4 v[4][4];
#pragma unroll
            for (int u = 0; u < 4; ++u) { const int m = m0 + u * NGW; if (m < M) { const f32x4* xr = (const f32x4*)(m < MP ? args.in[0] + (size_t)m * DM : args.in[1] + (size_t)(m - MP) * DM) + lane;
#pragma unroll
                for (int j = 0; j < 4; ++j) v[u][j] = xr[64 * j]; } }
#pragma unroll
            for (int u = 0; u < 4; ++u) { const int m = m0 + u * NGW; if (m < M) { float s = 0.f;
#pragma unroll
                for (int j = 0; j < 4; ++j) s += (v[u][j][0] * v[u][j][0] + v[u][j][1] * v[u][j][1]) + (v[u][j][2] * v[u][j][2] + v[u][j][3] * v[u][j][3]);
                s = wave_sum(s); if (lane == 0) rssx[m] = s;
                v2u* o8 = (v2u*)(XB + (size_t)m * DM) + lane;
#pragma unroll
                for (int j = 0; j < 4; ++j) o8[64 * j] = (v2u){pk_bf16(v[u][j][0], v[u][j][1]), pk_bf16(v[u][j][2], v[u][j][3])}; } }
        }
    }
    SEAM(0);
    if (IN(1)) {
        { sg::P sp{XB, Win_t, 1024, 4096, rssx, 1, lbv, S1, nullptr, out}; sg::phase<sg::IN>(lds, (unsigned)(uintptr_t)lds_raw, sp, vcu, G); }
        pg8::Gemm g{XB, Win_t, MP, 4096, 1024}; pg8::StaticOrder S; S.init(MP, 4096, G, bx);
        pg8::EpiIn E{rssx, lbv, S1};
        pg8::gemm_phase<pg8::EpiIn, pg8::StaticOrder, true, true>(lds, tabs, g, S, E);
    }
    SEAM(1);
    if (IN(2)) {
        if (bx >= 192) {
            LAS float* scr = (LAS float*)(lds + wave * 16384);
            constexpr int I_UP = 16 * 128, I_DN = 64 * 32, I_KV = 16 * 64, I_Q = 16 * 64, I_O = 16 * 32;
            constexpr int NITEMS = I_UP + I_DN + I_KV + I_Q + I_O + I_UP + I_DN;
            const int xw = (bx - 192) * NWAVES + wave, NXW = (G - 192) * NWAVES;
            for (int it = xw; it < NITEMS; it += NXW) {
                int r = it;
                if (r < I_UP) { p0_transpose_item(args.in[18], 1024, 4096, 128, args.in[17], Wup0_t, 0, scr, r, lane); continue; } r -= I_UP;
                if (r < I_DN) { p0_transpose_item(args.in[19], 4096, 1024, 32, nullptr, Wdn0_t, 0, scr, r, lane); continue; } r -= I_DN;
                if (r < I_KV) { p0_transpose_item(args.in[12], 1024, 2064, 64, args.in[11], Wkvq_t, 0, scr, r, lane); continue; } r -= I_KV;
                if (r < I_Q)  { p0_transpose_item(args.in[15], 1024, 2048, 64, args.in[14], Wkvq_t, 2048, scr, r, lane); continue; } r -= I_Q;
                if (r < I_O)  { p0_transpose_item(args.in[16], 1024, 1024, 32, nullptr, Wob_t, 0, scr, r, lane); continue; } r -= I_O;
                if (r < I_UP) { p0_transpose_item(args.in[18] + (size_t)1024 * 4096, 1024, 4096, 128, args.in[17] + 1024, Wup1_t, 0, scr, r, lane); continue; } r -= I_UP;
                p0_transpose_item(args.in[19] + (size_t)4096 * 1024, 4096, 1024, 32, nullptr, Wdn1_t, 0, scr, r, lane);
            }
            for (int e = xw * 64 + lane; e < 16 * 1024; e += NXW * 64) { const int n = e >> 10, k = e & 1023; Wlf_t[e] = (unsigned short)(pk_bf16(args.in[12][(size_t)k * 2064 + 2048 + n] * args.in[11][k], 0.f) & 0xffffu); }
        }
        for (int u = bx; u < 192; u += G) {
            const bool smp = u >= 128; const int b = smp ? (u - 128) >> 3 : u >> 3, h = u & 7;
            const float* s0 = smp ? args.in[2] + (size_t)(b * HA + h) * KA * KA : nullptr;
            float* sfin = out + (smp ? OST_S : OST_P) + (size_t)(b * HA + h) * KA * KA;
            gla::unit(lds, S1, args.dry_gla ? (bf16*)(ws + 470 * MiB) : S1, args.dry_gla ? 16383 : -1, S2, S3, S4, S5, args.in[9], smp ? MP + b * TS : b * TP, smp ? 1 : TP / CH, h, s0, sfin);
        }
    }
    SEAM(2);
    if (IN(3)) {
        { sg::P sp{S1, Wo_t, 1024, 1024, nullptr, 1, nullptr, XB, rssA, out}; sg::phase<sg::RES>(lds, (unsigned)(uintptr_t)lds_raw, sp, vcu, G); }
        pg8::Gemm g{S1, Wo_t, MP, 1024, 1024}; pg8::StaticOrder S; S.init(MP, 1024, G, bx);
        pg8::EpiRes E{XB, rssA};
        pg8::gemm_phase<pg8::EpiRes, pg8::StaticOrder, true, true>(lds, tabs, g, S, E);
    }
    SEAM(3);
    if (IN(4)) {
        { sg::P sp{XB, Wup0_t, 1024, 4096, rssA, 16, nullptr, S2, nullptr, out}; sg::phase<sg::UP>(lds, (unsigned)(uintptr_t)lds_raw, sp, vcu, G);
#ifdef PROBE_SG
          sg::phase<sg::UP>(lds, (unsigned)(uintptr_t)lds_raw, sp, vcu, G); sg::phase<sg::UP>(lds, (unsigned)(uintptr_t)lds_raw, sp, vcu, G); sg::phase<sg::UP>(lds, (unsigned)(uintptr_t)lds_raw, sp, vcu, G); sg::phase<sg::UP>(lds, (unsigned)(uintptr_t)lds_raw, sp, vcu, G);
#endif
        }
        pg8::Gemm g{XB, Wup0_t, MP, 4096, 1024}; pg8::StaticOrder S; S.init(MP, 4096, G, bx);
        pg8::EpiUp E{rssA, S2};
        pg8::gemm_phase<pg8::EpiUp, pg8::StaticOrder, true, true>(lds, tabs, g, S, E);
    }
    SEAM(4);
    if (IN(5)) {
        { sg::P sp{S2, Wdn0_t, 4096, 1024, nullptr, 1, nullptr, XB, rssB, out}; sg::phase<sg::RES>(lds, (unsigned)(uintptr_t)lds_raw, sp, vcu, G); }
        pg8::Gemm g{S2, Wdn0_t, MP, 1024, 4096}; pg8::StaticOrder S; S.init(MP, 1024, G, bx);
        pg8::EpiRes E{XB, rssB};
        pg8::gemm_phase<pg8::EpiRes, pg8::StaticOrder, true, true>(lds, tabs, g, S, E);
    }
    SEAM(5);
    if (IN(6)) {
        for (int rb = gw; rb < MP / 16; rb += NGW) {
            const int arow = 16 * rb + (lane & 15), kq = lane >> 4;
            const bf16* ap = XB + (size_t)arow * DM + 8 * kq; const bf16* bp = Wlf_t + (size_t)(lane & 15) * DM + 8 * kq;
            f32x4 acc = (f32x4){0.f, 0.f, 0.f, 0.f};
#pragma unroll 16
            for (int ks = 0; ks < 32; ++ks) { const bf16x8 a = *(const bf16x8*)(ap + 32 * ks), b = *(const bf16x8*)(bp + 32 * ks); acc = __builtin_amdgcn_mfma_f32_16x16x32_bf16(a, b, acc, 0, 0, 0); }
            const int col = lane & 15; const float bias = args.in[13][col];
#pragma unroll
            for (int i = 0; i < 4; ++i) { const int row = 16 * rb + 4 * kq + i;
                const f32x4* pp = (const f32x4*)(rssB + (size_t)row * 16); const f32x4 p0 = pp[0], p1 = pp[1], p2 = pp[2], p3 = pp[3];
                const float ss = (((p0[0] + p0[1]) + (p0[2] + p0[3])) + ((p1[0] + p1[1]) + (p1[2] + p1[3]))) + (((p2[0] + p2[1]) + (p2[2] + p2[3])) + ((p3[0] + p3[1]) + (p3[2] + p3[3])));
                const float z = acc[i] * rsqrtf(ss * (1.0f / 1024.0f) + EPS) + bias;
                out[OLF_P + (size_t)row * 16 + col] = z < 0.f ? z - log1pf(expf(z)) : -log1pf(expf(-z)); }
        }
        for (int d = gw; d < MS * HB; d += NGW) {
            const int row = MP + (d >> 4), col = d & 15;
            const v4u xa = *((const v4u*)(XB + (size_t)row * DM) + lane), xb = *((const v4u*)(XB + (size_t)row * DM) + 64 + lane);
            const v4u wa = *((const v4u*)(Wlf_t + (size_t)col * DM) + lane), wb = *((const v4u*)(Wlf_t + (size_t)col * DM) + 64 + lane);
            float s = bf_lo(xa.x) * bf_lo(wa.x) + bf_hi(xa.x) * bf_hi(wa.x) + bf_lo(xa.y) * bf_lo(wa.y) + bf_hi(xa.y) * bf_hi(wa.y) + bf_lo(xa.z) * bf_lo(wa.z) + bf_hi(xa.z) * bf_hi(wa.z) + bf_lo(xa.w) * bf_lo(wa.w) + bf_hi(xa.w) * bf_hi(wa.w)
                    + bf_lo(xb.x) * bf_lo(wb.x) + bf_hi(xb.x) * bf_hi(wb.x) + bf_lo(xb.y) * bf_lo(wb.y) + bf_hi(xb.y) * bf_hi(wb.y) + bf_lo(xb.z) * bf_lo(wb.z) + bf_hi(xb.z) * bf_hi(wb.z) + bf_lo(xb.w) * bf_lo(wb.w) + bf_hi(xb.w) * bf_hi(wb.w);
            s = wave_sum(s);
            float ssp = rssB[(size_t)row * 16 + (lane & 15)]; ssp += __shfl_xor(ssp, 1); ssp += __shfl_xor(ssp, 2); ssp += __shfl_xor(ssp, 4); ssp += __shfl_xor(ssp, 8);
            const float z = s * rsqrtf(ssp * (1.0f / 1024.0f) + EPS) + args.in[13][col];
            if (lane == 0) out[OLF_S + (size_t)(row - MP) * 16 + col] = z < 0.f ? z - log1pf(expf(z)) : -log1pf(expf(-z));
        }
        { sg::P sp{XB, Wkvq_t, 1024, 4096, rssB, 16, nullptr, S1, nullptr, out}; sg::phase<sg::KVQ>(lds, (unsigned)(uintptr_t)lds_raw, sp, vcu, G); }
        pg8::Gemm g{XB, Wkvq_t, MP, 4096, 1024}; pg8::StaticOrder S; S.init(MP, 4096, G, bx);
        pg8::EpiKvq E{rssB, S1, out, QSCALE};
        pg8::gemm_phase<pg8::EpiKvq, pg8::StaticOrder, true, true>(lds, tabs, g, S, E);
    }
    SEAM(6);
    if (IN(7)) {
        if (bx >= BP + BS) {
            const int NE = (G - (BP + BS)) * NWAVES * 64, e0 = (bx - (BP + BS)) * NWAVES * 64 + tid; constexpr int NV = MP * 128;
            for (int e = e0; e < 2 * NV; e += 8 * NE) { v4u xv[8];
#pragma unroll
                for (int u = 0; u < 8; ++u) { const int ee = e + u * NE; if (ee < 2 * NV) xv[u] = ((const v4u*)(ee < NV ? S1 : S2))[ee < NV ? ee : ee - NV]; }
#pragma unroll
                for (int u = 0; u < 8; ++u) { const int ee = e + u * NE; if (ee < 2 * NV) { const v4u x = xv[u]; f32x4* d = (f32x4*)(out + (ee < NV ? OK_P : OV_P)) + (size_t)(ee < NV ? ee : ee - NV) * 2;
                    d[0] = (f32x4){bf_lo(x.x), bf_hi(x.x), bf_lo(x.y), bf_hi(x.y)}; d[1] = (f32x4){bf_lo(x.z), bf_hi(x.z), bf_lo(x.w), bf_hi(x.w)}; } }
            }
        }
        LAS f32x4* segsum = (LAS f32x4*)lds;
        for (int task = bx; task < BP + BS; task += G) {
            const bool smp = task >= BP; const int b = smp ? task - BP : task, nitems = smp ? (SKV / 16) * 4 : (TP / 16) * 4;
#define P7_SRC(seg_, i_) (smp ? (16 * (seg_) + (i_) < PAST ? (const f32x4*)(args.in[5] + ((size_t)b * PAST + 16 * (seg_) + (i_)) * 16) : (const f32x4*)(out + OLF_S + (size_t)(b * TS + 16 * (seg_) + (i_) - PAST) * 16)) \
                              : (const f32x4*)(out + OLF_P + (size_t)(b * TP + 16 * (seg_) + (i_)) * 16))
            for (int it = tid; it < nitems; it += NWAVES * 64) { const int hg = it & 3, seg = it >> 2; f32x4 v[16];
#pragma unroll
                for (int i = 0; i < 16; ++i) v[i] = P7_SRC(seg, i)[hg];
                f32x4 s4 = v[0];
#pragma unroll
                for (int i = 1; i < 16; ++i) s4 += v[i];
                segsum[it] = s4; }
            __syncthreads();
            for (int it = tid; it < nitems; it += NWAVES * 64) { const int hg = it & 3, seg = it >> 2; f32x4 v[16];
#pragma unroll
                for (int i = 0; i < 16; ++i) v[i] = P7_SRC(seg, i)[hg];
                f32x4 run = (f32x4){0.f, 0.f, 0.f, 0.f};
                for (int q = 0; q < seg; ++q) run += segsum[q * 4 + hg];
                if (smp) { f32x4* dstF = (f32x4*)(Fs + ((size_t)b * SKV + 16 * seg) * 16) + hg;
#pragma unroll
                    for (int i = 0; i < 16; ++i) { run += v[i]; dstF[i * 4] = run; }
                } else {
                    f32x4 te = run;
                    for (int q = seg; q <= (seg | 3); ++q) te += segsum[q * 4 + hg];
#pragma unroll
                    for (int i = 0; i < 16; ++i) { run += v[i];
#pragma unroll
                        for (int k = 0; k < 4; ++k) { const float fr = (te[k] - run[k]) * LOG2E; const unsigned fh = pk_bf16(fr, 0.f) & 0xffffu;
                            ((unsigned*)(ws + WS_FKP))[(size_t)(b * HB + 4 * hg + k) * TP + 16 * seg + i] = fh | (pk_bf16(fr - __uint_as_float(fh << 16), 0.f) << 16); } }
                    if ((seg & 3) == 3) {
#pragma unroll
                        for (int k = 0; k < 4; ++k) ((float*)(ws + WS_CEND))[(b * HB + 4 * hg + k) * (TP / 64) + (seg >> 2)] = te[k] * LOG2E; }
                }
            }
#undef P7_SRC
            __syncthreads();
        }
    }
    SEAM(7);
    if (IN(8)) {
        volatile LAS int* qslot = (volatile LAS int*)(lds + MISC_OFF + 128);
        gu32* qhead = ctl + CW_ATT;
        if (tid == 0) qslot[0] = (int)__hip_atomic_fetch_add(qhead, 1u, RLX_AGENT);
        __syncthreads();
        int L = __builtin_amdgcn_readfirstlane(qslot[0]);
        while (L < 128 + 2048) {
            int pre = 0;
            if (tid == 0) pre = (int)__hip_atomic_fetch_add(qhead, 1u, RLX_AGENT);
            if (L < 128) { const int b = L >> 4, h = L & 15; const size_t qo = (size_t)(MP + b * TS) * DM + h * DH;
#ifndef NO_ATT3
                att3::unit(lds, (unsigned)(uintptr_t)lds_raw, S3 + qo, S4 + qo, S5 + qo, args.in[3] + (size_t)b * PAST * DM + h * DH, args.in[4] + (size_t)b * PAST * DM + h * DH, S1 + qo, S2 + qo, Fs + (size_t)b * SKV * 16 + h);
#endif
            } else { const int Lp = L - 128, qb = 7 - (Lp >> 8), b = (Lp >> 4) & 15, h = Lp & 15;
#ifndef NO_ATT2
                att2::attn_unit<8>(b, h, qb, S3, S1, S2, S4, S5, (const unsigned*)(ws + WS_FKP) + (size_t)(b * HB + h) * TP, (const float*)(ws + WS_CEND) + (b * HB + h) * (TP / 64), (char*)lds_raw);
#endif
            }
            if (tid == 0) qslot[0] = pre;
            __syncthreads();
            L = __builtin_amdgcn_readfirstlane(qslot[0]);
            __syncthreads();
        }
    }
    SEAM(8);
    if (IN(9)) {
        { sg::P sp{S5, Wob_t, 1024, 1024, nullptr, 1, nullptr, XB, rssA, out}; sg::phase<sg::RES>(lds, (unsigned)(uintptr_t)lds_raw, sp, vcu, G); }
        pg8::Gemm g{S5, Wob_t, MP, 1024, 1024}; pg8::StaticOrder S; S.init(MP, 1024, G, bx);
        pg8::EpiRes E{XB, rssA};
        pg8::gemm_phase<pg8::EpiRes, pg8::StaticOrder, true, true>(lds, tabs, g, S, E);
    }
    SEAM(9);
    if (IN(10)) {
        { sg::P sp{XB, Wup1_t, 1024, 4096, rssA, 16, nullptr, S1, nullptr, out}; sg::phase<sg::UP>(lds, (unsigned)(uintptr_t)lds_raw, sp, vcu, G); }
        pg8::Gemm g{XB, Wup1_t, MP, 4096, 1024}; pg8::StaticOrder S; S.init(MP, 4096, G, bx);
        pg8::EpiUp E{rssA, S1};
        pg8::gemm_phase<pg8::EpiUp, pg8::StaticOrder, true, true>(lds, tabs, g, S, E);
    }
    SEAM(10);
    if (IN(11)) {
        { sg::P sp{S1, Wdn1_t, 4096, 1024, nullptr, 1, nullptr, XB, rssB, out}; sg::phase<sg::RES>(lds, (unsigned)(uintptr_t)lds_raw, sp, vcu, G); }
        pg8::Gemm g{S1, Wdn1_t, MP, 1024, 4096}; pg8::StaticOrder S; S.init(MP, 1024, G, bx);
        pg8::EpiRes E{XB, rssB};
        pg8::gemm_phase<pg8::EpiRes, pg8::StaticOrder, true, true>(lds, tabs, g, S, E);
    }
    SEAM(11);
    if (IN(12)) {
        f32x4 gfv[4];
#pragma unroll
        for (int j = 0; j < 4; ++j) gfv[j] = ((const f32x4*)args.in[20])[64 * j + lane];
        for (int m0 = gw; m0 < M; m0 += 4 * NGW) {
            v2u xv[4][4]; float ps[4];
#pragma unroll
            for (int u = 0; u < 4; ++u) { const int m = m0 + u * NGW; if (m < M) { ps[u] = rssB[(size_t)m * 16 + (lane & 15)]; const v2u* xr = (const v2u*)(XB + (size_t)m * DM) + lane;
#pragma unroll
                for (int j = 0; j < 4; ++j) xv[u][j] = xr[64 * j]; } }
#pragma unroll
            for (int u = 0; u < 4; ++u) { const int m = m0 + u * NGW; if (m < M) { float p_ = ps[u]; p_ += __shfl_xor(p_, 1); p_ += __shfl_xor(p_, 2); p_ += __shfl_xor(p_, 4); p_ += __shfl_xor(p_, 8);
                const float rs = rsqrtf(p_ * (1.0f / 1024.0f) + EPS);
                f32x4* yo = (f32x4*)(m < MP ? out + OY_P + (size_t)m * DM : out + OY_S + (size_t)(m - MP) * DM) + lane;
#pragma unroll
                for (int j = 0; j < 4; ++j) { const v2u x = xv[u][j]; const f32x4 gg = gfv[j];
                    yo[64 * j] = (f32x4){bf_lo(x.x) * rs * gg[0], bf_hi(x.x) * rs * gg[1], bf_lo(x.y) * rs * gg[2], bf_hi(x.y) * rs * gg[3]}; } } }
        }
    }
#undef IN
#undef SEAM
#undef GRID_BAR
#undef ws
#undef out
#undef ctl
#undef lbv
#undef Wlf_t
#undef rssx
#undef rssA
#undef rssB
#undef Fs
#undef Win_t
#undef Wo_t
#undef Wup0_t
#undef Wdn0_t
#undef Wkvq_t
#undef Wob_t
#undef Wup1_t
#undef Wdn1_t
#undef XB
#undef S1
#undef S2
#undef S3
#undef S4
#undef S5
}

extern "C" void kernel_launch(void* const* d_in, const int* in_sizes, int n_in, void* d_out, int out_size, void* d_ws, size_t ws_size, hipStream_t stream) {
    static int grid = 0;
    if (grid == 0) {
        if (n_in != 21 || (size_t)out_size != OUT_END || ws_size < WS_END) { fprintf(stderr, "kernel_launch: unexpected shapes: n_in %d out %d ws %zu (need %zu)\n", n_in, out_size, ws_size, (size_t)WS_END); grid = -1; return; }
        int dev = 0, cus = 0, per_cu = 0;
        if (hipGetDevice(&dev) != hipSuccess || hipDeviceGetAttribute(&cus, hipDeviceAttributeMultiprocessorCount, dev) != hipSuccess) { grid = -1; return; }
        if (hipFuncSetAttribute((const void*)yoco_fwd, hipFuncAttributeMaxDynamicSharedMemorySize, LDS_BYTES) != hipSuccess) { fprintf(stderr, "kernel_launch: hipFuncSetAttribute failed\n"); grid = -1; return; }
        if (hipOccupancyMaxActiveBlocksPerMultiprocessor(&per_cu, (const void*)yoco_fwd, NWAVES * 64, LDS_BYTES) != hipSuccess || per_cu < 1) { fprintf(stderr, "kernel_launch: occupancy query reports %d blocks per CU\n", per_cu); }
        (void)hipGetLastError();
        grid = cus;
        fprintf(stderr, "kernel_launch: grid %d, occupancy %d per CU, ws %zu\n", grid, per_cu, ws_size);
    }
    if (grid < 0) return;
    if (hipMemsetAsync((char*)d_ws + WS_CTL, 0, CTL_ZERO_BYTES, stream) != hipSuccess) { fprintf(stderr, "kernel_launch: memset failed\n"); return; }
    Args a{};
    for (int i = 0; i < 21; ++i) a.in[i] = (const float*)d_in[i];
    a.out_ = (float*)d_out; a.ws_ = (unsigned char*)d_ws;
#ifndef PROBE_SPLIT
#define PROBE_SPLIT -1
#endif
    if (PROBE_SPLIT >= 0) {
        a.ph_lo = 0; a.ph_hi = PROBE_SPLIT + 1; a.dry_gla = (PROBE_SPLIT == 2); hipLaunchKernelGGL(yoco_fwd, dim3(grid), dim3(NWAVES * 64), LDS_BYTES, stream, a);
        (void)hipMemsetAsync((char*)d_ws + WS_CTL, 0, CTL_ZERO_BYTES, stream);
        a.ph_lo = PROBE_SPLIT; a.ph_hi = N_PHASES; a.dry_gla = 0; hipLaunchKernelGGL(yoco_fwd, dim3(grid), dim3(NWAVES * 64), LDS_BYTES, stream, a);
    } else if (N_LAUNCHES == 1) { a.ph_lo = 0; a.ph_hi = N_PHASES; hipLaunchKernelGGL(yoco_fwd, dim3(grid), dim3(NWAVES * 64), LDS_BYTES, stream, a); }
    else for (int p = 0; p < N_PHASES; ++p) { a.ph_lo = p; a.ph_hi = p + 1; hipLaunchKernelGGL(yoco_fwd, dim3(grid), dim3(NWAVES * 64), LDS_BYTES, stream, a); }
    const hipError_t le = hipPeekAtLastError();
    if (le != hipSuccess) fprintf(stderr, "kernel_launch: launch failed: %s\n", hipGetErrorName(le));
}
```

```cpp
#include <hip/hip_runtime.h>
#include <cstdio>
#include <cstdint>

constexpr int DM = 1024, FF = 4096;
constexpr int BP = 16, TP = 2048, BS = 8, TS = 64, PAST = 4096;
constexpr int MP = BP * TP, MS = BS * TS, M = MP + MS;
constexpr int HA = 8, KA = 128, HB = 16, DH = 64, CH = 64;
constexpr int SKV = PAST + TS;
constexpr float EPS = 1e-6f;
constexpr float LOG2E = 1.4426950408889634f;
constexpr float QSCALE = 0.125f * LOG2E;

constexpr size_t OY_P = 0, OY_S = 33554432, OST_P = 34078720, OK_P = 36175872, OV_P = 69730304, OLF_P = 103284736,
                 OST_S = 103809024, OK_S = 104857600, OV_S = 105381888, OLF_S = 105906176, OUT_END = 105914368;

constexpr size_t MiB = 1u << 20;
constexpr size_t WS_CTL = 0, CTL_ZERO_BYTES = 32768;
constexpr size_t WS_LB = 1 * MiB;
constexpr size_t WS_WLF = 1 * MiB + 65536;
constexpr size_t WS_RSSX = 2 * MiB;
constexpr size_t WS_RSSA = 3 * MiB, WS_RSSB = 6 * MiB;
constexpr size_t WS_FS = 11 * MiB;
constexpr size_t WS_WIN = 14 * MiB, WS_WO = 22 * MiB, WS_WUP0 = 24 * MiB, WS_WDN0 = 32 * MiB, WS_WKVQ = 40 * MiB, WS_WOB = 48 * MiB, WS_WUP1 = 50 * MiB, WS_WDN1 = 58 * MiB;
constexpr size_t SLAB = (size_t)M * DM * 2;
constexpr size_t WS_SLAB0 = 66 * MiB;
constexpr size_t WS_END = WS_SLAB0 + 6 * SLAB;
static_assert(SLAB == 65 * MiB && WS_END <= 512 * MiB, "workspace map");
constexpr size_t WS_FKP = 460 * MiB, WS_CEND = 462 * MiB;
constexpr int CW_BAR = 4096, CW_ATT = 64;

constexpr int RING_BYTES = 131072;
constexpr int TAB_OFF = RING_BYTES;
constexpr int LDS_BYTES = 147456;
constexpr int MISC_OFF = LDS_BYTES - 256;

#define GAS __attribute__((address_space(1)))
#define LAS __attribute__((address_space(3)))
typedef unsigned short bf16;
typedef unsigned v4u __attribute__((ext_vector_type(4)));
typedef unsigned v2u __attribute__((ext_vector_type(2)));
typedef float f32x4 __attribute__((ext_vector_type(4)));
typedef float f32x16 __attribute__((ext_vector_type(16)));
typedef short bf16x8 __attribute__((ext_vector_type(8)));
typedef short s16x4 __attribute__((ext_vector_type(4)));
typedef GAS unsigned gu32;
#define RLX_AGENT __ATOMIC_RELAXED, __HIP_MEMORY_SCOPE_AGENT
#define LDS_WAIT() asm volatile("s_waitcnt lgkmcnt(0)" ::: "memory")
#define VM_WAIT() asm volatile("s_waitcnt vmcnt(0)" ::: "memory")

typedef float f32x2_c __attribute__((ext_vector_type(2))); typedef __bf16 bf16x2_c __attribute__((ext_vector_type(2)));
__device__ __forceinline__ unsigned pk_bf16(float lo, float hi) { const f32x2_c v = {lo, hi}; return __builtin_bit_cast(unsigned, __builtin_convertvector(v, bf16x2_c)); }
__device__ __forceinline__ float bf_lo(unsigned u) { return __uint_as_float(u << 16); }
__device__ __forceinline__ float bf_hi(unsigned u) { return __uint_as_float(u & 0xffff0000u); }
__device__ __forceinline__ float bf2f(unsigned short u) { return __uint_as_float((unsigned)u << 16); }
__device__ __forceinline__ float sigmoidf_(float z) { return __builtin_amdgcn_rcpf(1.0f + __expf(-z)); }
__device__ __forceinline__ int crow(int r, int hi) { return (r & 3) + 8 * (r >> 2) + 4 * hi; }
__device__ __forceinline__ float wave_sum(float v) {
#pragma unroll
    for (int o = 1; o < 64; o <<= 1) v += __shfl_xor(v, o);
    return v;
}
namespace pg8 {
#define PG8_LAS __attribute__((address_space(3)))
typedef unsigned short bf16_t;
typedef short bf16x8 __attribute__((ext_vector_type(8)));
typedef float f32x4 __attribute__((ext_vector_type(4)));
typedef unsigned u32x4 __attribute__((ext_vector_type(4)));
constexpr int BM = 256, BK = 64, HALF = 128, HTB = HALF * BK * 2  , STAGE_BYTES = 8 * HTB, NXCD = 8, WGM = 8;

__host__ __device__ __forceinline__ int lds_byte(int r, int c) { const int st = (r >> 4) * 2 + (c >> 5), rr = r & 15, cc = c & 31, ob = rr * 64 + cc * 2; return st * 1024 + (ob ^ (((ob >> 9) & 1) << 5)); }
__host__ __device__ __forceinline__ void stage_rc(int b, int& R, int& C) { const int st = b / 1024, sb = b % 1024, swz = sb ^ (((sb >> 9) & 1) << 5); R = (st >> 1) * 16 + swz / 64; C = (st & 1) * 32 + (swz % 64) / 2; }
__host__ __device__ __forceinline__ int perm32(int rho) { const int n = rho >> 4, i = rho & 15; return 8 * (i >> 2) + 4 * n + (i & 3); }

struct Unit { int pm, pn; };
struct Gemm { const bf16_t* A; const bf16_t* Bt; int M, N, K; };

struct StaticOrder {
    int nM, nN, nwg, G, c;
    __host__ __device__ void init(int M, int N, int G_, int c_) { nM = M / BM; nN = N / BM; nwg = nM * nN; G = G_; c = c_; }
    __host__ __device__ bool next(int i, Unit& u) const {
        const long L = (long)i * G + c; if (L >= nwg) return false;
        int wgid = (int)L; { const int q = nwg / NXCD, r = nwg % NXCD, xcd = wgid % NXCD, off = wgid / NXCD; wgid = (xcd < r ? xcd * (q + 1) : r * (q + 1) + (xcd - r) * q) + off; }
        const int nig = WGM * nN, gid = wgid / nig, fm = gid * WGM, gsz = (nM - fm) < WGM ? (nM - fm) : WGM;
        u.pm = fm + ((wgid % nig) % gsz); u.pn = (wgid % nig) / gsz; return true;
    }
    __device__ __forceinline__ void a_ready(const Unit&) const {}
    __device__ __forceinline__ void done(const Unit&) const {}
};


constexpr size_t SLAB_ELEMS = (size_t)33280 * 1024;
__device__ __forceinline__ unsigned cvt_pk_bf16(float lo, float hi) { return pk_bf16(lo, hi); }
__device__ __forceinline__ float sigm(float z) { return __builtin_amdgcn_rcpf(1.0f + __expf(-z)); }
__device__ __forceinline__ void rs_from_full(PG8_LAS float* tab, const float* rss, int pm) {
    const int tid = threadIdx.x; if (tid < 256) tab[tid] = rsqrtf(rss[pm * 256 + tid] * (1.0f / 1024.0f) + 1e-6f);
}
__device__ __forceinline__ void rs_from_parts(PG8_LAS float* tab, const float* rss16, int pm) {
    const int tid = threadIdx.x, row = tid >> 1, hf = tid & 1;
    const f32x4* p = (const f32x4*)(rss16 + (size_t)(pm * 256 + row) * 16 + hf * 8); const f32x4 a = p[0], b = p[1];
    float s = ((a.x + a.y) + (a.z + a.w)) + ((b.x + b.y) + (b.z + b.w)); s += __shfl_xor(s, 1);
    if (!hf) tab[row] = rsqrtf(s * (1.0f / 1024.0f) + 1e-6f);
}
#define PG8_PACK8(v0, v1) ((u32x4){cvt_pk_bf16((v0)[0], (v0)[1]), cvt_pk_bf16((v0)[2], (v0)[3]), cvt_pk_bf16((v1)[0], (v1)[1]), cvt_pk_bf16((v1)[2], (v1)[3])})

struct EpiIn {
    static constexpr bool PERM = true, AFTER_DRAIN = false;
    const float* rss; const float* lb; bf16_t* slab1;
    __device__ __forceinline__ void prep(PG8_LAS float* tab, const Unit& u) const { rs_from_full(tab, rss, u.pm); }
    __device__ __forceinline__ void operator()(const f32x4 (&acc)[2][2][4][2], const Unit& u, int wr, int wc, int fr, int fq, const PG8_LAS float* rst) const {
        const int seg = u.pn >> 2, colt = (u.pn & 3) * BM + wc * 32 + 8 * fq;
        const int row0 = u.pm * BM + wr * 64 + fr;
        if (seg == 1) {
            f32x4 lbv[2][2];
#pragma unroll
            for (int bj = 0; bj < 2; ++bj)
#pragma unroll
                for (int n = 0; n < 2; ++n) lbv[bj][n] = *(const f32x4*)(lb + colt + bj * HALF + 4 * n);
            bf16_t* okk = slab1 + SLAB_ELEMS; bf16_t* olf = slab1 + 2 * SLAB_ELEMS;
#pragma unroll
            for (int ai = 0; ai < 2; ++ai)
#pragma unroll
                for (int m = 0; m < 4; ++m) { const float rs = rst[ai * HALF + wr * 64 + m * 16 + fr]; const size_t ro = (size_t)(row0 + ai * HALF + m * 16) * 1024 + colt;
#pragma unroll
                    for (int bj = 0; bj < 2; ++bj) { f32x4 kk[2], lf[2];
#pragma unroll
                        for (int n = 0; n < 2; ++n)
#pragma unroll
                            for (int j = 0; j < 4; ++j) { const float z = acc[ai][bj][m][n][j] * rs, l = lbv[bj][n][j], sg = sigm(z), om = 1.0f - l;
                                kk[n][j] = om * (1.0f - sg); lf[n][j] = __logf(l + om * sg); }
                        *(u32x4*)(okk + ro + bj * HALF) = PG8_PACK8(kk[0], kk[1]); *(u32x4*)(olf + ro + bj * HALF) = PG8_PACK8(lf[0], lf[1]); } }
        } else {
            bf16_t* o = slab1 + (size_t)(seg == 0 ? 0 : seg == 2 ? 3 : 4) * SLAB_ELEMS;
#pragma unroll
            for (int ai = 0; ai < 2; ++ai)
#pragma unroll
                for (int m = 0; m < 4; ++m) { const float rs = rst[ai * HALF + wr * 64 + m * 16 + fr]; const size_t ro = (size_t)(row0 + ai * HALF + m * 16) * 1024 + colt;
#pragma unroll
                    for (int bj = 0; bj < 2; ++bj) { f32x4 v[2];
#pragma unroll
                        for (int n = 0; n < 2; ++n)
#pragma unroll
                            for (int j = 0; j < 4; ++j) { const float z = acc[ai][bj][m][n][j] * rs; v[n][j] = seg == 2 ? z : (seg == 0 ? z * sigm(z) : sigm(z)); }
                        *(u32x4*)(o + ro + bj * HALF) = PG8_PACK8(v[0], v[1]); } }
        }
    }
};
struct EpiRes {
    static constexpr bool PERM = true, AFTER_DRAIN = false;
    bf16_t* XB; float* rss_out;
    __device__ __forceinline__ void prep(PG8_LAS float*, const Unit&) const {}
    __device__ __forceinline__ void operator()(const f32x4 (&acc)[2][2][4][2], const Unit& u, int wr, int wc, int fr, int fq, const PG8_LAS float*) const {
        const int row0 = u.pm * BM + wr * 64 + fr, col0 = u.pn * BM + wc * 32 + 8 * fq;
#pragma unroll
        for (int ai = 0; ai < 2; ++ai)
#pragma unroll
            for (int m = 0; m < 4; ++m) { const int row = row0 + ai * HALF + m * 16; bf16_t* rowp = XB + (size_t)row * 1024 + col0; float s = 0.f;
#pragma unroll
                for (int bj = 0; bj < 2; ++bj) { const u32x4 old = *(const u32x4*)(rowp + bj * HALF); f32x4 v0 = acc[ai][bj][m][0], v1 = acc[ai][bj][m][1];
                    v0[0] += __uint_as_float(old.x << 16); v0[1] += __uint_as_float(old.x & 0xffff0000u); v0[2] += __uint_as_float(old.y << 16); v0[3] += __uint_as_float(old.y & 0xffff0000u);
                    v1[0] += __uint_as_float(old.z << 16); v1[1] += __uint_as_float(old.z & 0xffff0000u); v1[2] += __uint_as_float(old.w << 16); v1[3] += __uint_as_float(old.w & 0xffff0000u);
                    s += (v0[0] * v0[0] + v0[1] * v0[1]) + (v0[2] * v0[2] + v0[3] * v0[3]) + (v1[0] * v1[0] + v1[1] * v1[1]) + (v1[2] * v1[2] + v1[3] * v1[3]);
                    *(u32x4*)(rowp + bj * HALF) = PG8_PACK8(v0, v1); }
                s += __shfl_xor(s, 16); s += __shfl_xor(s, 32);
                if (fq == 0) rss_out[(size_t)row * 16 + u.pn * 4 + wc] = s; }
    }
};
struct EpiUp {
    static constexpr bool PERM = true, AFTER_DRAIN = false;
    const float* rss16; bf16_t* H;
    __device__ __forceinline__ void prep(PG8_LAS float* tab, const Unit& u) const { rs_from_parts(tab, rss16, u.pm); }
    __device__ __forceinline__ void operator()(const f32x4 (&acc)[2][2][4][2], const Unit& u, int wr, int wc, int fr, int fq, const PG8_LAS float* rst) const {
        const int row0 = u.pm * BM + wr * 64 + fr, col0 = u.pn * BM + wc * 32 + 8 * fq;
#pragma unroll
        for (int ai = 0; ai < 2; ++ai)
#pragma unroll
            for (int m = 0; m < 4; ++m) { const float rs = rst[ai * HALF + wr * 64 + m * 16 + fr]; bf16_t* rowp = H + (size_t)(row0 + ai * HALF + m * 16) * 4096 + col0;
#pragma unroll
                for (int bj = 0; bj < 2; ++bj) { f32x4 v[2];
#pragma unroll
                    for (int n = 0; n < 2; ++n)
#pragma unroll
                        for (int j = 0; j < 4; ++j) { const float z = fmaxf(acc[ai][bj][m][n][j] * rs, 0.f); v[n][j] = z * z; }
                    *(u32x4*)(rowp + bj * HALF) = PG8_PACK8(v[0], v[1]); } }
    }
};
struct EpiKvq {
    static constexpr bool PERM = true, AFTER_DRAIN = false;
    const float* rss16; bf16_t* slab1; float* out; float qscale;
    __device__ __forceinline__ void prep(PG8_LAS float* tab, const Unit& u) const { rs_from_parts(tab, rss16, u.pm); }
    __device__ __forceinline__ void operator()(const f32x4 (&acc)[2][2][4][2], const Unit& u, int wr, int wc, int fr, int fq, const PG8_LAS float* rst) const {
        const int seg = u.pn >> 2, colt = (u.pn & 3) * BM + wc * 32 + 8 * fq;
        const int row0 = u.pm * BM + wr * 64 + fr;
        bf16_t* o = slab1 + (size_t)seg * SLAB_ELEMS;
#pragma unroll
        for (int ai = 0; ai < 2; ++ai)
#pragma unroll
            for (int m = 0; m < 4; ++m) { const float rs = rst[ai * HALF + wr * 64 + m * 16 + fr]; const size_t ro = (size_t)(row0 + ai * HALF + m * 16) * 1024 + colt;
#pragma unroll
                for (int bj = 0; bj < 2; ++bj) { f32x4 v[2];
#pragma unroll
                    for (int n = 0; n < 2; ++n)
#pragma unroll
                        for (int j = 0; j < 4; ++j) { const float z = acc[ai][bj][m][n][j] * rs; v[n][j] = seg == 2 ? z * qscale : (seg == 3 ? sigm(z) : z); }
                    *(u32x4*)(o + ro + bj * HALF) = PG8_PACK8(v[0], v[1]); } }
    }
};

template <class Epi, class Sched, bool ALIGN_EPI = false, bool SP2 = false>
__device__ __forceinline__ void gemm_phase(PG8_LAS unsigned char* lds, PG8_LAS float* tabs, const Gemm g, const Sched& S, const Epi& E) {
    const int tid = threadIdx.x, wid = __builtin_amdgcn_readfirstlane(tid >> 6), lane = tid & 63, wr = wid >> 2, wc = wid & 3, fr = lane & 15, fq = lane >> 4;
    const int K = g.K, nt = K / BK;
    unsigned voffA[2], voffB[2];
#pragma unroll
    for (int i = 0; i < 2; ++i) { int R, C; stage_rc(tid * 16 + i * 8192, R, C); const int Rb = Epi::PERM ? ((R & ~31) + perm32(R & 31)) : R;
        voffA[i] = (unsigned)(R * K + C) * 2u; voffB[i] = (unsigned)(Rb * K + C) * 2u; }
    const size_t kstep = (size_t)(BK * 2);
    const size_t hstep = (size_t)HALF * K * 2;
    const size_t tstep = 2 * hstep;
    const unsigned ldsw = (unsigned)wid * 1024u;
    const int aoff = lds_byte(wr * 64 + fr, fq * 8), boff = lds_byte(wc * 32 + fr, fq * 8);
#define PG8_SA(b, h) (((b) * 2 + (h)) * HTB)
#define PG8_SB(b, h) ((4 + (b) * 2 + (h)) * HTB)
#define PG8_STAGE(bufoff, gbase, voff) do { _Pragma("unroll") for (int _i = 0; _i < 2; ++_i) \
        __builtin_amdgcn_global_load_lds((const unsigned*)((const char*)(gbase) + (voff)[_i]), (PG8_LAS unsigned*)(lds + (bufoff) + ldsw + _i * 8192), 16, 0, 0); } while (0)
#define PG8_LDA(dst, b, h) do { _Pragma("unroll") for (int m = 0; m < 4; ++m) _Pragma("unroll") for (int k = 0; k < 2; ++k) dst[m][k] = *(const PG8_LAS bf16x8*)(lds + PG8_SA(b, h) + aoff + m * 2048 + k * 1024); } while (0)
#define PG8_LDB(dst, b, h) do { _Pragma("unroll") for (int n = 0; n < 2; ++n) _Pragma("unroll") for (int k = 0; k < 2; ++k) dst[n][k] = *(const PG8_LAS bf16x8*)(lds + PG8_SB(b, h) + boff + n * 2048 + k * 1024); } while (0)
#define PG8_MMA(ai, bj, At, Bt) do { __builtin_amdgcn_s_setprio(1); _Pragma("unroll") for (int m = 0; m < 4; ++m) _Pragma("unroll") for (int n = 0; n < 2; ++n) _Pragma("unroll") for (int k = 0; k < 2; ++k) \
        acc[ai][bj][m][n] = __builtin_amdgcn_mfma_f32_16x16x32_bf16(Bt[n][k], At[m][k], acc[ai][bj][m][n], 0, 0, 0); __builtin_amdgcn_s_setprio(0); } while (0)
#define PG8_WAIT_V(n) asm volatile("s_waitcnt vmcnt(" #n ")" ::: "memory")
#define PG8_WAIT_L(n) asm volatile("s_waitcnt lgkmcnt(" #n ")" ::: "memory")
#define PG8_BAR __builtin_amdgcn_s_barrier()
#define PG8_SCHED __builtin_amdgcn_sched_barrier(0)
    Unit cur, nxt; int ui = 0;
    if (!S.next(0, cur)) return;
    f32x4 acc[2][2][4][2];
#pragma unroll
    for (int a = 0; a < 2; ++a)
#pragma unroll
        for (int b = 0; b < 2; ++b)
#pragma unroll
            for (int m = 0; m < 4; ++m)
#pragma unroll
                for (int n = 0; n < 2; ++n) acc[a][b][m][n] = (f32x4){0.f, 0.f, 0.f, 0.f};
    bf16x8 At[4][2], B0[2][2], B1[2][2];
    const char* cA = (const char*)g.A + (size_t)cur.pm * tstep; const char* cB = (const char*)g.Bt + (size_t)cur.pn * tstep;
    S.a_ready(cur);
    { Unit pu; for (int i = 0; i < 8 && S.next(i, pu); ++i) E.prep(tabs + (i << 8), pu); }
    if constexpr (SP2) {
        PG8_STAGE(PG8_SB(0, 0), cB, voffB); PG8_STAGE(PG8_SB(0, 1), cB + hstep, voffB); PG8_STAGE(PG8_SA(0, 0), cA, voffA); PG8_STAGE(PG8_SA(0, 1), cA + hstep, voffA);
        if (wr == 1) PG8_BAR;
        PG8_WAIT_V(2); PG8_BAR;
        PG8_STAGE(PG8_SB(1, 0), cB + kstep, voffB); PG8_STAGE(PG8_SA(1, 0), cA + kstep, voffA); PG8_STAGE(PG8_SB(1, 1), cB + hstep + kstep, voffB);
        PG8_WAIT_V(6); PG8_BAR;
    } else {
        PG8_STAGE(PG8_SB(0, 0), cB, voffB); PG8_STAGE(PG8_SA(0, 0), cA, voffA); PG8_STAGE(PG8_SB(0, 1), cB + hstep, voffB); PG8_STAGE(PG8_SA(0, 1), cA + hstep, voffA);
        if (wr == 1) PG8_BAR;
        PG8_WAIT_V(4); PG8_BAR;
        PG8_STAGE(PG8_SB(1, 0), cB + kstep, voffB); PG8_STAGE(PG8_SA(1, 0), cA + kstep, voffA); PG8_STAGE(PG8_SB(1, 1), cB + hstep + kstep, voffB);
        PG8_WAIT_V(6); PG8_BAR;
    }
    for (;;) {
        const bool has_next = S.next(ui + 1, nxt);
        const char* nA = has_next ? (const char*)g.A + (size_t)nxt.pm * tstep : cA; const char* nB = has_next ? (const char*)g.Bt + (size_t)nxt.pn * tstep : cB;
        for (int t = 0; t < nt; t += 2) {
            const bool last = (t == nt - 2);
            const char* a1 = cA + (size_t)(t + 1) * kstep;
            const char* a2 = last ? nA : cA + (size_t)(t + 2) * kstep; const char* b2 = last ? nB : cB + (size_t)(t + 2) * kstep;
            const char* a3 = a2 + kstep; const char* b3 = b2 + kstep;
            if (last && has_next) S.a_ready(nxt);
            if constexpr (SP2) {
            PG8_LDB(B0, 0, 0); PG8_LDB(B1, 0, 1); PG8_SCHED; PG8_LDA(At, 0, 0); PG8_STAGE(PG8_SA(1, 1), a1 + hstep, voffA);
            PG8_WAIT_V(8); PG8_WAIT_L(0); PG8_BAR; PG8_MMA(0, 0, At, B0); PG8_MMA(0, 1, At, B1); PG8_BAR; PG8_SCHED;
            PG8_LDA(At, 0, 1); PG8_STAGE(PG8_SB(0, 0), b2, voffB); PG8_STAGE(PG8_SB(0, 1), b2 + hstep, voffB); PG8_STAGE(PG8_SA(0, 0), a2, voffA);
            PG8_WAIT_V(8); PG8_WAIT_L(0); PG8_BAR; PG8_MMA(1, 0, At, B0); PG8_MMA(1, 1, At, B1); PG8_BAR; PG8_SCHED;
            PG8_LDB(B0, 1, 0); PG8_LDB(B1, 1, 1); PG8_SCHED; PG8_LDA(At, 1, 0); PG8_STAGE(PG8_SA(0, 1), a2 + hstep, voffA);
            PG8_WAIT_V(8); PG8_WAIT_L(0); PG8_BAR; PG8_MMA(0, 0, At, B0); PG8_MMA(0, 1, At, B1); PG8_BAR; PG8_SCHED;
            PG8_LDA(At, 1, 1); PG8_STAGE(PG8_SB(1, 0), b3, voffB); PG8_STAGE(PG8_SB(1, 1), b3 + hstep, voffB); PG8_STAGE(PG8_SA(1, 0), a3, voffA);
            PG8_WAIT_V(8); PG8_WAIT_L(0); PG8_BAR; PG8_MMA(1, 0, At, B0); PG8_MMA(1, 1, At, B1); PG8_BAR; PG8_SCHED;
            } else {
            PG8_LDB(B0, 0, 0); PG8_SCHED; PG8_LDA(At, 0, 0); PG8_STAGE(PG8_SA(1, 1), a1 + hstep, voffA);
            PG8_WAIT_L(8); PG8_BAR; PG8_WAIT_L(0); PG8_MMA(0, 0, At, B0); PG8_BAR; PG8_SCHED;
            PG8_LDB(B1, 0, 1); PG8_STAGE(PG8_SB(0, 0), b2, voffB);
            PG8_BAR; PG8_WAIT_L(0); PG8_MMA(0, 1, At, B1); PG8_BAR;
            PG8_LDA(At, 0, 1); PG8_STAGE(PG8_SA(0, 0), a2, voffA);
            PG8_BAR; PG8_WAIT_L(0); PG8_MMA(1, 0, At, B0); PG8_BAR; PG8_SCHED;
            PG8_STAGE(PG8_SB(0, 1), b2 + hstep, voffB);
            PG8_WAIT_V(6); PG8_BAR; PG8_MMA(1, 1, At, B1); PG8_BAR;
            PG8_LDB(B0, 1, 0); PG8_SCHED; PG8_LDA(At, 1, 0); PG8_STAGE(PG8_SA(0, 1), a2 + hstep, voffA);
            PG8_WAIT_L(8); PG8_BAR; PG8_WAIT_L(0); PG8_MMA(0, 0, At, B0); PG8_BAR; PG8_SCHED;
            PG8_LDB(B1, 1, 1); PG8_STAGE(PG8_SB(1, 0), b3, voffB);
            PG8_BAR; PG8_WAIT_L(0); PG8_MMA(0, 1, At, B1); PG8_BAR;
            PG8_LDA(At, 1, 1); PG8_STAGE(PG8_SA(1, 0), a3, voffA);
            PG8_BAR; PG8_WAIT_L(0); PG8_MMA(1, 0, At, B0); PG8_BAR; PG8_SCHED;
            PG8_STAGE(PG8_SB(1, 1), b3 + hstep, voffB);
            PG8_WAIT_V(6); PG8_BAR; PG8_MMA(1, 1, At, B1); PG8_BAR;
            }
        }
        if constexpr (ALIGN_EPI) { if (wr == 0) PG8_BAR; }
        if constexpr (!Epi::AFTER_DRAIN) { E(acc, cur, wr, wc, fr, fq, tabs + (ui << 8)); S.done(cur); }
        if (!has_next) break;
#pragma unroll
        for (int a = 0; a < 2; ++a)
#pragma unroll
            for (int b = 0; b < 2; ++b)
#pragma unroll
                for (int m = 0; m < 4; ++m)
#pragma unroll
                    for (int n = 0; n < 2; ++n) acc[a][b][m][n] = (f32x4){0.f, 0.f, 0.f, 0.f};
        cur = nxt; cA = nA; cB = nB; ++ui;
        if constexpr (ALIGN_EPI) { if (wr == 1) PG8_BAR; }
    }
    PG8_WAIT_V(0);
    if constexpr (!ALIGN_EPI) { if (wr == 0) PG8_BAR; }
    PG8_BAR;
    if constexpr (Epi::AFTER_DRAIN) { E.fused(acc, cur, wr, wc, fr, fq, lds, wid, lane); S.done(cur); }
#undef PG8_SA
#undef PG8_SB
#undef PG8_STAGE
#undef PG8_LDA
#undef PG8_LDB
#undef PG8_MMA
#undef PG8_WAIT_V
#undef PG8_WAIT_L
#undef PG8_BAR
#undef PG8_SCHED
}
}
#define XB_TMO      128
#define XB_XCNT(j)  (256  + 64 * (j))
#define XB_XSUB(j)  (1280 + 64 * (j))
#define XB_XGEN(j)  (2304 + 64 * (j))
#define XB_TOP      3328
#define XB_TOPGEN   3392
#define XCD_BAR_WORDS 3456
#define XB_SPIN_CAP (1u << 18)

__device__ __forceinline__ unsigned xb_ld(unsigned* p)              { return __hip_atomic_load(p, __ATOMIC_RELAXED, __HIP_MEMORY_SCOPE_AGENT); }
__device__ __forceinline__ unsigned xb_add(unsigned* p, unsigned v) { return __hip_atomic_fetch_add(p, v, __ATOMIC_RELAXED, __HIP_MEMORY_SCOPE_AGENT); }
__device__ __forceinline__ unsigned xb_xcc_id() { return (unsigned)__builtin_amdgcn_s_getreg((3 << 11) | 20) & 0xFu; }
#define XB_SPIN(cond, bar) do { unsigned _sp = 0; while (cond) { __builtin_amdgcn_s_sleep(1); \
    if ((++_sp & 255u) == 0u) { if (xb_ld(&(bar)[XB_TMO])) break; if (_sp > XB_SPIN_CAP) { atomicAdd(&(bar)[XB_TMO], 1u); break; } } } } while (0)

struct XcdBarrier {
    unsigned* bar; unsigned x;
    volatile LAS unsigned* st;
};

__device__ __forceinline__ XcdBarrier xcd_barrier_post(unsigned* bar, volatile LAS unsigned* st) {
    XcdBarrier b; b.bar = bar; b.x = xb_xcc_id(); b.st = st;
    if (threadIdx.x == 0) (void)xb_add(&bar[XB_XCNT(b.x)], 1u);
    return b;
}
__device__ __forceinline__ void xcd_barrier_complete(unsigned* bar, unsigned x, unsigned& nloc, unsigned& nx) {
    const unsigned G = gridDim.x * gridDim.y * gridDim.z;
    unsigned sum, cnt, mine, sp = 0u;
    for (;;) {
        sum = 0u; cnt = 0u; mine = 0u;
#pragma unroll
        for (unsigned j = 0; j < 16; ++j) { const unsigned c = xb_ld(&bar[XB_XCNT(j)]); sum += c; cnt += (c > 0u) ? 1u : 0u; mine = (j == x) ? c : mine; }
        if (sum == G) break;
        __builtin_amdgcn_s_sleep(1);
        if ((++sp & 255u) == 0u) { if (xb_ld(&bar[XB_TMO])) break; if (sp > XB_SPIN_CAP) { atomicAdd(&bar[XB_TMO], 1u); break; } }
    }
    nloc = mine > 0u ? mine : 1u; nx = cnt > 0u ? cnt : 1u;
}

__device__ __forceinline__ void xcd_barrier(const XcdBarrier& b) {
    asm volatile("s_waitcnt vmcnt(0)" ::: "memory");
    __syncthreads();
    if (threadIdx.x == 0) {
        unsigned* bar = b.bar;
        __builtin_amdgcn_s_waitcnt(0);
        unsigned nloc = b.st[0], nx = b.st[1];
        if (nloc == 0u) { xcd_barrier_complete(bar, b.x, nloc, nx); b.st[0] = nloc; b.st[1] = nx; }
        const unsigned old = xb_add(&bar[XB_XSUB(b.x)], 1u);
        const unsigned gen = old / nloc;
        if (old + 1u == (gen + 1u) * nloc) {
            __builtin_amdgcn_fence(__ATOMIC_RELEASE, "agent");
            asm volatile("s_waitcnt vmcnt(0)" ::: "memory");
            const unsigned og = xb_add(&bar[XB_TOP], 1u);
            const unsigned tg = og / nx;
            if (og + 1u == (tg + 1u) * nx) xb_add(&bar[XB_TOPGEN], 1u);
            else XB_SPIN(xb_ld(&bar[XB_TOPGEN]) == tg, bar);
            __builtin_amdgcn_fence(__ATOMIC_ACQUIRE, "agent");
            xb_add(&bar[XB_XGEN(b.x)], 1u);
            asm volatile("s_waitcnt vmcnt(0)" ::: "memory");
        } else {
            XB_SPIN(xb_ld(&bar[XB_XGEN(b.x)]) == gen, bar);
            __builtin_amdgcn_fence(__ATOMIC_ACQUIRE, "agent");
            asm volatile("s_waitcnt vmcnt(0)" ::: "memory");
        }
    }
    __syncthreads();
}

namespace gla {
constexpr int L_QD = 0, L_KI = 16384, L_KE = 32768, L_VV = 49152, L_OT = 65536, OT_PITCH = 528, L_XCH = 65536, L_QTOT = 99328, L_DK = 103424, L_SS = 103936, L_END = 104960;
static_assert(L_OT + 64 * OT_PITCH <= L_QTOT && L_XCH + 32768 <= L_QTOT && L_END <= RING_BYTES, "gla LDS map");
__device__ __forceinline__ s16x4 vtr(const LAS unsigned char* p) { typedef short v4i16_t __attribute__((ext_vector_type(4))); return __builtin_bit_cast(s16x4, __builtin_amdgcn_ds_read_tr16_b64_v4i16((LAS v4i16_t*)p)); }
#define GLA_MFMA(a, b, c) __builtin_amdgcn_mfma_f32_32x32x16_bf16(a, b, c, 0, 0, 0)
__device__ __forceinline__ void unit(LAS unsigned char* lds, const bf16* Q, bf16* Oout, int omask, const bf16* KK, const bf16* LF, const bf16* I, const bf16* G, const float* gnorm,
                                     int row0, int nchunks, int h, const float* s0, float* sfin) {
    const int tid = threadIdx.x, lane = tid & 63, r = lane & 31, hi = lane >> 5; const int w = __builtin_amdgcn_readfirstlane(tid >> 6);
    const int vt = w & 3, hf = w >> 2;
    f32x16 S[4];
#pragma unroll
    for (int kt = 0; kt < 4; ++kt)
#pragma unroll
        for (int g = 0; g < 16; ++g) S[kt][g] = s0 ? s0[(size_t)(32 * kt + crow(g, hi)) * 128 + 32 * vt + r] : 0.f;
    float gn8[8];
#pragma unroll
    for (int j = 0; j < 8; ++j) gn8[j] = gnorm[8 * (tid & 15) + j];
    LAS float* qtot = (LAS float*)(lds + L_QTOT); LAS float* dk = (LAS float*)(lds + L_DK); LAS float* ssl = (LAS float*)(lds + L_SS);
    unsigned lfr[8], qvr[8], kvr[8]; v4u vxr[2];
#define GLA_LOAD(nn) do { const int mm_ = row0 + 64 * (nn); const size_t go_ = (size_t)(mm_ + 8 * w) * DM + h * 128 + 2 * lane; \
        _Pragma("unroll") for (int i = 0; i < 8; ++i) { lfr[i] = *(const unsigned*)(LF + go_ + (size_t)i * DM); qvr[i] = *(const unsigned*)(Q + go_ + (size_t)i * DM); kvr[i] = *(const unsigned*)(KK + go_ + (size_t)i * DM); } \
        _Pragma("unroll") for (int j = 0; j < 2; ++j) { const int p_ = tid + 512 * j; vxr[j] = *(const v4u*)(I + (size_t)(mm_ + (p_ >> 4)) * DM + h * 128 + 8 * (p_ & 15)); } } while (0)
    GLA_LOAD(0);
    for (int n = 0; n < nchunks; ++n) {
        const int m0 = row0 + 64 * n;
        int tid_ = threadIdx.x; asm volatile("" : "+v"(tid_));
        const int tid = tid_, lane = tid & 63, r = lane & 31, hi = lane >> 5;
        {
            float c0[8], c1[8]; float run0 = 0.f, run1 = 0.f;
#pragma unroll
            for (int i = 0; i < 8; ++i) { run0 += bf_lo(lfr[i]); run1 += bf_hi(lfr[i]); c0[i] = run0; c1[i] = run1; }
            typedef float f32x2_t __attribute__((ext_vector_type(2)));
            LAS f32x2_t* qtot2 = (LAS f32x2_t*)qtot;
            qtot2[w * 64 + lane] = (f32x2_t){run0, run1};
#pragma unroll
            for (int j = 0; j < 2; ++j) { const int p = tid + 512 * j, s = p >> 4, v8 = p & 15;
                *(LAS v4u*)(lds + L_VV + (v8 >> 2) * 4096 + s * 64 + (v8 & 3) * 16) = vxr[j]; }
            __syncthreads();
            float pre0 = 0.f, pre1 = 0.f, bt0 = 0.f, bt1 = 0.f;
#pragma unroll
            for (int ww = 0; ww < 8; ++ww) { const f32x2_t t_ = qtot2[ww * 64 + lane]; bt0 += t_[0]; bt1 += t_[1]; if (ww < w) { pre0 += t_[0]; pre1 += t_[1]; } }
            const float eb0 = __expf(bt0), eb1 = __expf(bt1);
#pragma unroll
            for (int i = 0; i < 8; ++i) { const int t = 8 * w + i; const float e0 = __expf(pre0 + c0[i]), e1 = __expf(pre1 + c1[i]);
                const float ki0 = bf_lo(kvr[i]) * __builtin_amdgcn_rcpf(e0), ki1 = bf_hi(kvr[i]) * __builtin_amdgcn_rcpf(e1);
                const int ro = t * 256 + ((((lane >> 2) ^ (t & 15))) << 4) + (lane & 3) * 4;
                *(LAS unsigned*)(lds + L_QD + ro) = pk_bf16(bf_lo(qvr[i]) * e0, bf_hi(qvr[i]) * e1);
                *(LAS unsigned*)(lds + L_KI + ro) = pk_bf16(ki0, ki1);
                *(LAS unsigned*)(lds + L_KE + (lane >> 4) * 4096 + t * 64 + (lane & 15) * 4) = pk_bf16(ki0 * eb0, ki1 * eb1); }
            if (w == 0) { dk[2 * lane] = eb0; dk[2 * lane + 1] = eb1; }
            if (n + 1 < nchunks) GLA_LOAD(n + 1);
            __syncthreads();
        }
        v4u ggr[2];
#pragma unroll
        for (int j = 0; j < 2; ++j) { const int p = tid + 512 * j; ggr[j] = *(const v4u*)(G + (size_t)(m0 + (p >> 4)) * DM + h * 128 + 8 * (p & 15)); }
        f32x16 o;
#pragma unroll
        for (int g = 0; g < 16; ++g) o[g] = 0.f;
        {
            const int row = 32 * hf + r;
#pragma unroll
            for (int kt = 0; kt < 4; ++kt)
#pragma unroll
                for (int ksl = 0; ksl < 2; ++ksl) {
                    const int chunk = 4 * kt + 2 * ksl;
                    const v2u b0 = *(const LAS v2u*)(lds + L_QD + row * 256 + (((chunk) ^ (row & 15)) << 4) + 8 * hi);
                    const v2u b1 = *(const LAS v2u*)(lds + L_QD + row * 256 + (((chunk + 1) ^ (row & 15)) << 4) + 8 * hi);
                    const v4u bq = (v4u){b0.x, b0.y, b1.x, b1.y};
                    const v4u aq = (v4u){pk_bf16(S[kt][8 * ksl + 0], S[kt][8 * ksl + 1]), pk_bf16(S[kt][8 * ksl + 2], S[kt][8 * ksl + 3]),
                                         pk_bf16(S[kt][8 * ksl + 4], S[kt][8 * ksl + 5]), pk_bf16(S[kt][8 * ksl + 6], S[kt][8 * ksl + 7])};
                    o = GLA_MFMA(__builtin_bit_cast(bf16x8, aq), __builtin_bit_cast(bf16x8, bq), o);
                }
        }
        bf16x8 vf[4];
        {
            const LAS unsigned char* vb = lds + L_VV + vt * 4096 + ((lane >> 4) & 1) * 32 + (lane & 3) * 8 + (4 * hi + ((lane & 15) >> 2)) * 64;
#pragma unroll
            for (int ks = 0; ks < 4; ++ks) { const s16x4 lo = vtr(vb + ks * 1024), hh = vtr(vb + ks * 1024 + 512); vf[ks] = (bf16x8){lo[0], lo[1], lo[2], lo[3], hh[0], hh[1], hh[2], hh[3]}; }
        }
        for (int st = 0; st <= hf; ++st) {
            f32x16 X;
#pragma unroll
            for (int g = 0; g < 16; ++g) X[g] = 0.f;
            const int rs_ = 32 * st + r, rt_ = 32 * hf + r;
#pragma unroll
            for (int k8 = 0; k8 < 8; ++k8) {
                const bf16x8 a = *(const LAS bf16x8*)(lds + L_KI + rs_ * 256 + (((2 * k8 + hi) ^ (rs_ & 15)) << 4));
                const bf16x8 b = *(const LAS bf16x8*)(lds + L_QD + rt_ * 256 + (((2 * k8 + hi) ^ (rt_ & 15)) << 4));
                X = GLA_MFMA(a, b, X);
            }
            if (st == hf) {
#pragma unroll
                for (int g = 0; g < 16; ++g) if (crow(g, hi) > r) X[g] = 0.f;
            }
            const v4u x0 = (v4u){pk_bf16(X[0], X[1]), pk_bf16(X[2], X[3]), pk_bf16(X[4], X[5]), pk_bf16(X[6], X[7])};
            const v4u x1 = (v4u){pk_bf16(X[8], X[9]), pk_bf16(X[10], X[11]), pk_bf16(X[12], X[13]), pk_bf16(X[14], X[15])};
            if (st == 0) { o = GLA_MFMA(vf[0], __builtin_bit_cast(bf16x8, x0), o); o = GLA_MFMA(vf[1], __builtin_bit_cast(bf16x8, x1), o); }
            else         { o = GLA_MFMA(vf[2], __builtin_bit_cast(bf16x8, x0), o); o = GLA_MFMA(vf[3], __builtin_bit_cast(bf16x8, x1), o); }
        }
#pragma unroll
        for (int kt = 0; kt < 4; ++kt) {
#pragma unroll
            for (int j = 0; j < 4; ++j) { const f32x4 d4 = *(const LAS f32x4*)(dk + 32 * kt + 8 * j + 4 * hi);
                S[kt][4 * j + 0] *= d4[0]; S[kt][4 * j + 1] *= d4[1]; S[kt][4 * j + 2] *= d4[2]; S[kt][4 * j + 3] *= d4[3]; }
            const LAS unsigned char* kb = lds + L_KE + kt * 4096 + ((lane >> 4) & 1) * 32 + (lane & 3) * 8 + (4 * hi + ((lane & 15) >> 2)) * 64;
#pragma unroll
            for (int ks = 0; ks < 4; ++ks) { const s16x4 lo = vtr(kb + ks * 1024), hh = vtr(kb + ks * 1024 + 512);
                const bf16x8 a = (bf16x8){lo[0], lo[1], lo[2], lo[3], hh[0], hh[1], hh[2], hh[3]};
                S[kt] = GLA_MFMA(a, vf[ks], S[kt]); }
        }
        {
            float ssq = 0.f;
#pragma unroll
            for (int g = 0; g < 16; ++g) ssq += o[g] * o[g];
            ssq += __shfl_xor(ssq, 32);
            const int t = 32 * hf + r;
            if (hi == 0) ssl[vt * 64 + t] = ssq;
#pragma unroll
            for (int j = 0; j < 4; ++j) *(LAS f32x4*)(lds + L_OT + t * OT_PITCH + (32 * vt + 8 * j + 4 * hi) * 4) = (f32x4){o[4 * j], o[4 * j + 1], o[4 * j + 2], o[4 * j + 3]};
        }
        __syncthreads();
#pragma unroll
        for (int j = 0; j < 2; ++j) { const int p = tid + 512 * j, t = p >> 4, c8 = p & 15;
            const float rn = rsqrtf(((ssl[t] + ssl[64 + t]) + (ssl[128 + t] + ssl[192 + t])) * (1.0f / 128.0f) + EPS);
            const f32x4 a = *(const LAS f32x4*)(lds + L_OT + t * OT_PITCH + c8 * 32), b = *(const LAS f32x4*)(lds + L_OT + t * OT_PITCH + c8 * 32 + 16);
            const v4u gg = ggr[j];
            v4u ov; ov.x = pk_bf16(a[0] * rn * gn8[0] * bf_lo(gg.x), a[1] * rn * gn8[1] * bf_hi(gg.x)); ov.y = pk_bf16(a[2] * rn * gn8[2] * bf_lo(gg.y), a[3] * rn * gn8[3] * bf_hi(gg.y));
            ov.z = pk_bf16(b[0] * rn * gn8[4] * bf_lo(gg.z), b[1] * rn * gn8[5] * bf_hi(gg.z)); ov.w = pk_bf16(b[2] * rn * gn8[6] * bf_lo(gg.w), b[3] * rn * gn8[7] * bf_hi(gg.w));
            *(v4u*)(Oout + (size_t)((m0 + t) & omask) * DM + h * 128 + 8 * c8) = ov; }
    }
    if (hf == 0) {
#pragma unroll
        for (int kt = 0; kt < 4; ++kt)
#pragma unroll
            for (int g = 0; g < 16; ++g) sfin[(size_t)(32 * kt + crow(g, hi)) * 128 + 32 * vt + r] = S[kt][g]; }
    __syncthreads();
}
#undef GLA_MFMA
#undef GLA_LOAD
}

namespace att2 {
using bf16x8=__attribute__((ext_vector_type(8)))short;
using s16x4=__attribute__((ext_vector_type(4)))short;
using f32x16=__attribute__((ext_vector_type(16)))float;
using u32x4=__attribute__((ext_vector_type(4)))unsigned;
constexpr int NHEAD=16,SEQ=2048,D=64,DM=NHEAD*D;
constexpr int NW=8,QBLK=32,QB=QBLK*NW,KVBLK=64,NQB=SEQ/QB;
constexpr int ATTN_PITCH=DM, ATTN_UNIT_ROWS=QB;
__device__ __forceinline__ int crow(int r,int hi){return (r&3)+8*(r>>2)+4*hi;}
#define SBAR() __builtin_amdgcn_sched_barrier(0)
__device__ __forceinline__ void cmask(f32x16&p0,f32x16&p1,int jb,int qrel,int hi){
  const float NEG=-__builtin_inff(); int kb=64*jb+4*hi;
  #pragma unroll
  for(int r=0;r<16;++r){int kv=kb+(r&3)+8*(r>>2); if(kv>qrel)p0[r]=NEG; if(kv+32>qrel)p1[r]=NEG;}
}

constexpr int NSLOT=3, SLOTB=8192;
constexpr int LDS_K=0, LDS_V=NSLOT*SLOTB, LDS_WS=2*NSLOT*SLOTB, LDS_OST=LDS_WS+NW*64*4, LDS_FK=LDS_OST+NW*4096, LDS_CJ=LDS_FK+8192, LDS_BYTES=LDS_CJ+256;
constexpr float C2=0.125f*1.4426950408889634f;
__device__ __forceinline__ void glds16(const void*gsrc,unsigned lds_dst){unsigned keep;
  asm volatile("s_mov_b32 %0, m0\n\ts_mov_b32 m0, %2\n\ts_nop 0\n\tglobal_load_lds_dwordx4 %1, off\n\ts_mov_b32 m0, %0":"=&s"(keep):"v"(gsrc),"s"(lds_dst):"memory");}
__device__ __forceinline__ float max3f(float a,float b,float c){float r;asm("v_max3_f32 %0, %1, %2, %3":"=v"(r):"v"(a),"v"(b),"v"(c));return r;}
__device__ __forceinline__ float max2f(float a,float b){float r;asm("v_max_f32_e32 %0, %1, %2":"=v"(r):"v"(a),"v"(b));return r;}
__device__ __forceinline__ float fadd_s(float a,float b){float r;asm("v_add_f32_e32 %0, %1, %2":"=v"(r):"v"(a),"v"(b));return r;}
__device__ __forceinline__ float fsub_s(float a,float b){float r;asm("v_sub_f32_e32 %0, %1, %2":"=v"(r):"v"(a),"v"(b));return r;}
typedef float f32x2_t __attribute__((ext_vector_type(2))); typedef __bf16 bf16x2_t __attribute__((ext_vector_type(2)));
__device__ __forceinline__ unsigned cvtpk_s(float lo,float hi){f32x2_t v={lo,hi};bf16x2_t b=__builtin_convertvector(v,bf16x2_t);return __builtin_bit_cast(unsigned,b);}
#define WAIT_BAR(N) asm volatile("s_waitcnt vmcnt(" #N ") lgkmcnt(0)\n\ts_barrier":::"memory")

__device__ __forceinline__ void qkt(f32x16&p0,f32x16&p1,const char*Kslot,const bf16x8*qr,int r32,int hi){
  const char*kb=Kslot+hi*1024+r32*16;
  #pragma unroll
  for(int d0=0;d0<4;++d0){
    const bf16x8 b0=*reinterpret_cast<const bf16x8*>(kb+d0*2048);
    const bf16x8 b1=*reinterpret_cast<const bf16x8*>(kb+d0*2048+512);
    p0=__builtin_amdgcn_mfma_f32_32x32x16_bf16(b0,qr[d0],p0,0,0,0);p1=__builtin_amdgcn_mfma_f32_32x32x16_bf16(b1,qr[d0],p1,0,0,0);}
}
typedef __attribute__((address_space(3))) const char* lds_cptr;
typedef short v4i16_t __attribute__((ext_vector_type(4)));
__device__ __forceinline__ void kload8(bf16x8*kf,lds_cptr kp){
  kf[0]=*(const __attribute__((address_space(3))) bf16x8*)(kp);      kf[1]=*(const __attribute__((address_space(3))) bf16x8*)(kp+512);
  kf[2]=*(const __attribute__((address_space(3))) bf16x8*)(kp+2048); kf[3]=*(const __attribute__((address_space(3))) bf16x8*)(kp+2560);
  kf[4]=*(const __attribute__((address_space(3))) bf16x8*)(kp+4096); kf[5]=*(const __attribute__((address_space(3))) bf16x8*)(kp+4608);
  kf[6]=*(const __attribute__((address_space(3))) bf16x8*)(kp+6144); kf[7]=*(const __attribute__((address_space(3))) bf16x8*)(kp+6656);
}
__device__ __forceinline__ void kload2(bf16x8*kf,lds_cptr kp,int j){ kf[2*j]=*(const __attribute__((address_space(3))) bf16x8*)(kp+j*2048); kf[2*j+1]=*(const __attribute__((address_space(3))) bf16x8*)(kp+j*2048+512); }
__device__ __forceinline__ s16x4 vtr(lds_cptr p){ return __builtin_bit_cast(s16x4,__builtin_amdgcn_ds_read_tr16_b64_v4i16((__attribute__((address_space(3))) v4i16_t*)p)); }
__device__ __forceinline__ float rowmax(const f32x16&p0,const f32x16&p1){
  float a=max3f(p0[0],p0[1],p1[0]),b=max3f(p0[2],p0[3],p1[1]);a=max3f(a,p1[2],p1[3]);
  #pragma unroll
  for(int r=4;r<16;r+=4){a=max3f(a,p0[r],p0[r+1]);b=max3f(b,p0[r+2],p0[r+3]);a=max3f(a,p1[r],p1[r+1]);b=max3f(b,p1[r+2],p1[r+3]);}
  const float m=max2f(a,b);
  auto rr=__builtin_amdgcn_permlane32_swap(__float_as_uint(m),__float_as_uint(m),false,false);
  return max2f(__uint_as_float(rr[0]),__uint_as_float(rr[1]));
}
__device__ __forceinline__ void pv(f32x16*o,int vb,bf16x8 pa0,bf16x8 pa1,bf16x8 pa2,bf16x8 pa3){
  #pragma unroll
  for(int d0=0;d0<2;++d0){s16x4 lo[4],hi[4];
    #pragma unroll
    for(int ks=0;ks<4;++ks){
      asm volatile("ds_read_b64_tr_b16 %0,%1 offset:%c2":"=&v"(lo[ks]):"v"(vb),"i"(d0*4096+ks*1024):"memory");
      asm volatile("ds_read_b64_tr_b16 %0,%1 offset:%c2":"=&v"(hi[ks]):"v"(vb),"i"(d0*4096+ks*1024+512):"memory");}
    asm volatile("s_waitcnt lgkmcnt(0)":::"memory");SBAR();
    #define PK(k) (bf16x8){lo[k][0],lo[k][1],lo[k][2],lo[k][3],hi[k][0],hi[k][1],hi[k][2],hi[k][3]}
    o[d0]=__builtin_amdgcn_mfma_f32_32x32x16_bf16(pa0,PK(0),o[d0],0,0,0);
    o[d0]=__builtin_amdgcn_mfma_f32_32x32x16_bf16(pa1,PK(1),o[d0],0,0,0);
    o[d0]=__builtin_amdgcn_mfma_f32_32x32x16_bf16(pa2,PK(2),o[d0],0,0,0);
    o[d0]=__builtin_amdgcn_mfma_f32_32x32x16_bf16(pa3,PK(3),o[d0],0,0,0);
    #undef PK
  }
}

#ifndef ATTN_STORE16
#define ATTN_STORE16(p,v) (*(u32x4*)(p)=(v))
#endif
template<int THRL> __device__ __forceinline__ void attn_unit(int b,int h,int qb,const bf16*Q,const bf16*__restrict__ K,const bf16*__restrict__ V,const bf16*__restrict__ G,bf16*O,const unsigned*__restrict__ FKP,const float*__restrict__ CEND,char*shm){
  int tid_=threadIdx.x; asm volatile("":"+v"(tid_));
  const int tid=tid_,lane=tid&63,r32=lane&31,hi=lane>>5; const int wid=__builtin_amdgcn_readfirstlane(tid>>6);
  const long rowbase=(long)b*SEQ; const int q0=qb*QB;
  const bf16*Qw=Q+(rowbase+q0+wid*QBLK)*DM+h*D;
  const bf16*Kh=K+rowbase*DM+h*D,*Vh=V+rowbase*DM+h*D;
  const unsigned lds0=(unsigned)(uintptr_t)shm;
  float*wsf=(float*)(shm+LDS_WS)+wid*64;
  const float*wsh=wsf+4*hi;
  const bf16*ksrc=Kh+(long)lane*DM+wid*8;
  const bf16*vsrc=Vh+(long)(16*(wid&3)+(lane>>2))*DM+(wid>>2)*32+(lane&3)*8;
  const unsigned kdst=lds0+LDS_K+wid*1024, vdst=lds0+LDS_V+wid*1024;
  #define DMA_K(t,slot) glds16(ksrc+(long)(NT-1-(t))*KVBLK*DM,(unsigned)__builtin_amdgcn_readfirstlane(kdst+(slot)))
  #define DMA_V(t,slot) glds16(vsrc+(long)(NT-1-(t))*KVBLK*DM,(unsigned)__builtin_amdgcn_readfirstlane(vdst+(slot)))
  const int vb0=(int)(lds0+LDS_V)+((lane>>4)&1)*32+(lane&3)*8+(4*hi+((lane&15)>>2))*64;
  const char*Kbase=shm+LDS_K; bf16x8 kf[8];
  const lds_cptr shm3=(lds_cptr)shm; const lds_cptr kp0=shm3+LDS_K+hi*1024+r32*16; const lds_cptr vp0=shm3+LDS_V+((lane>>4)&1)*32+(lane&3)*8+(4*hi+((lane&15)>>2))*64;
  const int NT=(q0+QB)/KVBLK;
  DMA_K(0,0);DMA_V(0,0);DMA_K(1,SLOTB);
  unsigned*fkl=(unsigned*)(shm+LDS_FK); float*cjl=(float*)(shm+LDS_CJ);
  { const float cref=CEND[NT-1]; _Pragma("unroll") for(int k_=0;k_<4;++k_){const int i=tid+k_*NW*64; if(i<NT*KVBLK)fkl[i]=FKP[i];} if(tid<NT)cjl[tid]=cref-CEND[tid]; }
  bf16x8 qr[4];
  #pragma unroll
  for(int d0=0;d0<4;++d0)qr[d0]=*reinterpret_cast<const bf16x8*>(&Qw[(long)r32*DM+d0*16+hi*8]);
  float mhat=0.f,l_reg=0.f;f32x16 o[2];o[0]=f32x16{};o[1]=f32x16{};
  const unsigned ONES=0x3f803f80u;
  unsigned fk0c=0u,fk1c=0u; float cjc=0.f;
  #define BIAS_LD(t) do{ const int tl_=NT-1-(t); fk0c=fkl[tl_*KVBLK+r32]; fk1c=fkl[tl_*KVBLK+32+r32]; cjc=cjl[tl_]; }while(0)
  #define BIAS_OPS(t) const unsigned fk0_=fk0c,fk1_=fk1c; const float cj_=cjc; \
    const float x_=cj_-mhat; const unsigned xh_=cvtpk_s(x_,0.f)&0xffffu; const float xhf_=__uint_as_float(xh_<<16); const float xl_=x_-xhf_; const unsigned xp_=xh_|(cvtpk_s(xl_,0.f)<<16); \
    mhat=cj_-(xhf_+__uint_as_float(xp_&0xffff0000u)); \
    const u32x4 kx0_={fk0_,ONES,0u,0u},kx1_={fk1_,ONES,0u,0u},qx_={hi?0u:ONES,hi?0u:xp_,0u,0u}; const f32x16 z16_=f32x16{};
  #define CMASK(P0,P1,t) do{int jb_=3-(t); if(jb_>=0)cmask(P0,P1,jb_,wid*QBLK+r32,hi);}while(0)
  bool resc=false;
  #define START(P0,P1) do{ const float rm=__builtin_fmaxf(rowmax(P0,P1),-1.0e4f); resc=false; \
    { const float dl=rm; mhat=fadd_s(mhat,dl); \
      _Pragma("unroll") for(int r=0;r<16;++r){P0[r]=fsub_s(P0[r],dl);P1[r]=fsub_s(P1[r],dl);} } \
    _Pragma("unroll") for(int r=0;r<16;++r)P0[r]=__builtin_amdgcn_exp2f(P0[r]); }while(0)
  #define RESC() do{ if(resc){ asm volatile("s_waitcnt lgkmcnt(0)":::"memory"); \
      _Pragma("unroll") for(int d_=0;d_<2;++d_) _Pragma("unroll") for(int r=0;r<16;++r)o[d_][r]*=wsh[(r&3)+8*(r>>2)]; } }while(0)
  f32x16 pA0,pA1,pB0,pB1;
  int sl_prev=0,sl_cur=0,sl_next=SLOTB;
  #define ROT() do{sl_prev=sl_cur;sl_cur=sl_next;sl_next=(sl_next==(NSLOT-1)*SLOTB)?0:sl_next+SLOTB;}while(0)
  DMA_K(2,2*SLOTB);
  WAIT_BAR(3);
  BIAS_LD(0);
  { BIAS_OPS(0); pA0=__builtin_amdgcn_mfma_f32_32x32x16_bf16(__builtin_bit_cast(bf16x8,kx0_),__builtin_bit_cast(bf16x8,qx_),z16_,0,0,0); pA1=__builtin_amdgcn_mfma_f32_32x32x16_bf16(__builtin_bit_cast(bf16x8,kx1_),__builtin_bit_cast(bf16x8,qx_),z16_,0,0,0); }
  BIAS_LD(1);
  qkt(pA0,pA1,Kbase,qr,r32,hi);asm volatile("s_nop 15\n\ts_nop 7":"+v"(pA0),"+v"(pA1));CMASK(pA0,pA1,0);
  START(pA0,pA1);
  _Pragma("unroll") for(int r=0;r<16;++r)pA1[r]=__builtin_amdgcn_exp2f(pA1[r]);
  WAIT_BAR(0);
  DMA_K(3,0);DMA_V(1,SLOTB);
  ROT();
  kload8(kf,kp0+sl_cur);
  WAIT_BAR(2);
  s16x4 vlo[8],vhi[8]; u32x4 pw0,pw1,pw2,pw3;
  #define PKW(P,B) cvtpk_s(P[B],P[B+1])
  #define PAF(k) __builtin_bit_cast(bf16x8,pw##k)
  #define VFR(i) (bf16x8){vlo[i][0],vlo[i][1],vlo[i][2],vlo[i][3],vhi[i][0],vhi[i][1],vhi[i][2],vhi[i][3]}
  #define PIN(x) asm volatile("":"+v"(x))
  #define MX3(a,b,c) __builtin_fmaxf(__builtin_fmaxf((a),(b)),(c))
  #define GAPA(MF,A0,A1,A2,A3,W0,W1,PW) do{ MF; sacc+=A0; sacc+=A1; sacc+=A2; sacc+=A3; PIN(sacc); W0; W1; PIN(PW); SBAR(); }while(0)
  #define EX(v) __builtin_amdgcn_exp2f(v)
  #define GAPB(MF,X,B) do{ MF; X[B]=EX(X[B]); X[B+1]=EX(X[B+1]); X[B+2]=EX(X[B+2]); X[B+3]=EX(X[B+3]); PIN(X); SBAR(); }while(0)
  #define VRD(i) do{ vlo[i]=vtr(vp_+(((i)>>2)*4096+((i)&3)*1024)); vhi[i]=vtr(vp_+(((i)>>2)*4096+((i)&3)*1024+512)); }while(0)
  #define KRD(G,j) do{ if(G){ kload2(kf,kp0+sl_next,j); SBAR(); } }while(0)
  #define STEP(C0,C1,P0,P1,t,GK,GV,GL) do{ SBAR(); \
    const lds_cptr vp_=vp0+sl_prev; \
    { BIAS_OPS(t) \
      C0=__builtin_amdgcn_mfma_f32_32x32x16_bf16(__builtin_bit_cast(bf16x8,kx0_),__builtin_bit_cast(bf16x8,qx_),z16_,0,0,0); \
      C1=__builtin_amdgcn_mfma_f32_32x32x16_bf16(__builtin_bit_cast(bf16x8,kx1_),__builtin_bit_cast(bf16x8,qx_),z16_,0,0,0); } SBAR(); \
    VRD(0); SBAR(); float sacc=(P0[0]+P0[1]); \
    GAPA(C0=__builtin_amdgcn_mfma_f32_32x32x16_bf16(kf[0],qr[0],C0,0,0,0), P0[2],P0[3],P0[4],P0[5],     pw0[0]=PKW(P0,0), pw0[1]=PKW(P0,2), pw0); \
    VRD(4); SBAR(); GAPA(C1=__builtin_amdgcn_mfma_f32_32x32x16_bf16(kf[1],qr[0],C1,0,0,0), P0[6],P0[7],P0[8],P0[9],     pw0[2]=PKW(P0,4), pw0[3]=PKW(P0,6), pw0); \
    VRD(1); SBAR(); GAPA(C0=__builtin_amdgcn_mfma_f32_32x32x16_bf16(kf[2],qr[1],C0,0,0,0),   P0[10],P0[11],P0[12],P0[13], pw1[0]=PKW(P0,8), pw1[1]=PKW(P0,10), pw1); \
    VRD(5); SBAR(); GAPA(C1=__builtin_amdgcn_mfma_f32_32x32x16_bf16(kf[3],qr[1],C1,0,0,0),   P0[14],P0[15],P1[0],P1[1],   pw1[2]=PKW(P0,12),pw1[3]=PKW(P0,14), pw1); \
    VRD(2); SBAR(); GAPA(C0=__builtin_amdgcn_mfma_f32_32x32x16_bf16(kf[4],qr[2],C0,0,0,0),   P1[2],P1[3],P1[4],P1[5],     pw2[0]=PKW(P1,0), pw2[1]=PKW(P1,2), pw2); \
    VRD(6); SBAR(); GAPA(C1=__builtin_amdgcn_mfma_f32_32x32x16_bf16(kf[5],qr[2],C1,0,0,0),   P1[6],P1[7],P1[8],P1[9],     pw2[2]=PKW(P1,4), pw2[3]=PKW(P1,6), pw2); \
    VRD(3); SBAR(); GAPA(C0=__builtin_amdgcn_mfma_f32_32x32x16_bf16(kf[6],qr[3],C0,0,0,0),   P1[10],P1[11],P1[12],P1[13], pw3[0]=PKW(P1,8), pw3[1]=PKW(P1,10), pw3); \
    VRD(7); SBAR(); GAPA(C1=__builtin_amdgcn_mfma_f32_32x32x16_bf16(kf[7],qr[3],C1,0,0,0),   P1[14],P1[15],0.f,0.f,       pw3[2]=PKW(P1,12),pw3[3]=PKW(P1,14), pw3); \
    l_reg+=sacc; \
    if(GK){DMA_K((t)+3,sl_cur);} if(GV){DMA_V((t)+1,sl_next);} \
    CMASK(C0,C1,t); \
    { float a=MX3(C0[0],C0[1],C1[0]),b=MX3(C0[2],C0[3],C1[1]); a=MX3(a,C1[2],C1[3]); \
      _Pragma("unroll") for(int r=4;r<16;r+=4){a=MX3(a,C0[r],C0[r+1]);b=MX3(b,C0[r+2],C0[r+3]);a=MX3(a,C1[r],C1[r+1]);b=MX3(b,C1[r+2],C1[r+3]);} \
      float rm=__builtin_fmaxf(a,b); { auto rr=__builtin_amdgcn_permlane32_swap(__float_as_uint(rm),__float_as_uint(rm),false,false); rm=__builtin_fmaxf(__uint_as_float(rr[0]),__uint_as_float(rr[1])); } \
      resc=false; \
      if(__builtin_expect(__any(rm>(float)THRL),0)){ const float dl=__builtin_fmaxf(rm,0.f); mhat+=dl; \
        _Pragma("unroll") for(int r=0;r<16;++r){C0[r]-=dl;C1[r]-=dl;} \
        const float f=__builtin_amdgcn_exp2f(-dl); l_reg*=f; if(hi==0)wsf[r32]=f; resc=true; } } \
    if(GV){BIAS_LD((t)+1);} \
    SBAR(); \
    GAPB(o[0]=__builtin_amdgcn_mfma_f32_32x32x16_bf16(PAF(0),VFR(0),o[0],0,0,0), C0,0); \
    GAPB(o[1]=__builtin_amdgcn_mfma_f32_32x32x16_bf16(PAF(0),VFR(4),o[1],0,0,0), C0,4); \
    KRD(GL,0); GAPB(o[0]=__builtin_amdgcn_mfma_f32_32x32x16_bf16(PAF(1),VFR(1),o[0],0,0,0), C0,8); \
    KRD(GL,1); GAPB(o[1]=__builtin_amdgcn_mfma_f32_32x32x16_bf16(PAF(1),VFR(5),o[1],0,0,0), C0,12); \
    KRD(GL,2); GAPB(o[0]=__builtin_amdgcn_mfma_f32_32x32x16_bf16(PAF(2),VFR(2),o[0],0,0,0), C1,0); \
    KRD(GL,3); GAPB(o[1]=__builtin_amdgcn_mfma_f32_32x32x16_bf16(PAF(2),VFR(6),o[1],0,0,0), C1,4); \
    GAPB(o[0]=__builtin_amdgcn_mfma_f32_32x32x16_bf16(PAF(3),VFR(3),o[0],0,0,0), C1,8); \
    GAPB(o[1]=__builtin_amdgcn_mfma_f32_32x32x16_bf16(PAF(3),VFR(7),o[1],0,0,0), C1,12); \
    }while(0)
  int t=1;
  #define ENDW(tt) do{ if((tt)+3<NT){WAIT_BAR(2);} else if((tt)+2<NT){WAIT_BAR(1);} else {WAIT_BAR(0);} }while(0)
  for(;t<5&&t+1<NT;t+=2){
    STEP(pB0,pB1,pA0,pA1,t,(t+3<NT),(t+1<NT),(t+1<NT));       ENDW(t);   RESC(); ROT();
    STEP(pA0,pA1,pB0,pB1,t+1,(t+4<NT),(t+2<NT),(t+2<NT));     ENDW(t+1); RESC(); ROT();
  }
  #undef CMASK
  #define CMASK(P0,P1,t) do{}while(0)
  for(;t+5<NT;t+=2){
    STEP(pB0,pB1,pA0,pA1,t,true,true,true);     WAIT_BAR(2); RESC(); ROT();
    STEP(pA0,pA1,pB0,pB1,t+1,true,true,true);   WAIT_BAR(2); RESC(); ROT();
  }
  for(;t+1<NT;t+=2){
    STEP(pB0,pB1,pA0,pA1,t,(t+3<NT),(t+1<NT),(t+1<NT));       ENDW(t);   RESC(); ROT();
    STEP(pA0,pA1,pB0,pB1,t+1,(t+4<NT),(t+2<NT),(t+2<NT));     ENDW(t+1); RESC(); ROT();
  }
  #undef CMASK
  #define CMASK(P0,P1,t) do{int jb_=3-(t); if(jb_>=0)cmask(P0,P1,jb_,wid*QBLK+r32,hi);}while(0)
  const bf16*Gw=G+(rowbase+q0+wid*QBLK)*DM+h*D; u32x4 ggp[4];
  #pragma unroll
  for(int i=0;i<4;++i)ggp[i]=*(const u32x4*)(Gw+(long)(i*8+(lane>>3))*DM+(lane&7)*8);
  STEP(pB0,pB1,pA0,pA1,NT-1,false,false,false); RESC();
  { float sacc=pB0[0]+pB0[1]; _Pragma("unroll") for(int r=2;r<16;++r)sacc+=pB0[r]; _Pragma("unroll") for(int r=0;r<16;++r)sacc+=pB1[r]; l_reg+=sacc;
    pw0=(u32x4){PKW(pB0,0),PKW(pB0,2),PKW(pB0,4),PKW(pB0,6)};pw1=(u32x4){PKW(pB0,8),PKW(pB0,10),PKW(pB0,12),PKW(pB0,14)};pw2=(u32x4){PKW(pB1,0),PKW(pB1,2),PKW(pB1,4),PKW(pB1,6)};pw3=(u32x4){PKW(pB1,8),PKW(pB1,10),PKW(pB1,12),PKW(pB1,14)};
    SBAR(); pv(o,vb0+sl_cur,PAF(0),PAF(1),PAF(2),PAF(3)); }
  #undef PKW
  #undef PAF
  #undef VFR
  #undef PIN
  #undef MX3
  #undef GAPA
  #undef GAPB
  #undef EX
  #undef VRD
  #undef KRD
  #undef STEP
  #undef ENDW
  {auto rr=__builtin_amdgcn_permlane32_swap(__float_as_uint(l_reg),__float_as_uint(l_reg),false,false);l_reg=__uint_as_float(rr[0])+__uint_as_float(rr[1]);}
  if(hi==0)wsf[32+r32]=l_reg;asm volatile("s_waitcnt lgkmcnt(0)":::"memory");
  float rli[16];
  #pragma unroll
  for(int r=0;r<16;++r)rli[r]=__builtin_amdgcn_rcpf(wsh[32+(r&3)+8*(r>>2)]);
  bf16*Ow=O+(rowbase+q0+wid*QBLK)*DM+h*D;
  { bf16*stg=(bf16*)(shm+LDS_OST)+wid*2048;
    #pragma unroll
    for(int r=0;r<16;++r){const int orow=crow(r,hi);
      #pragma unroll
      for(int d0=0;d0<2;++d0)stg[orow*64+d0*32+r32]=(unsigned short)(cvtpk_s(o[d0][r]*rli[r],0.f)&0xffffu);}
    asm volatile("s_waitcnt lgkmcnt(0)":::"memory");
    #pragma unroll
    for(int i=0;i<4;++i){const int row=i*8+(lane>>3),ch=lane&7; const u32x4 v=*(const u32x4*)(stg+row*64+ch*8); const u32x4 gg=ggp[i]; u32x4 ov;
      ov.x=cvtpk_s(__uint_as_float(v.x<<16)*__uint_as_float(gg.x<<16),__uint_as_float(v.x&0xffff0000u)*__uint_as_float(gg.x&0xffff0000u)); ov.y=cvtpk_s(__uint_as_float(v.y<<16)*__uint_as_float(gg.y<<16),__uint_as_float(v.y&0xffff0000u)*__uint_as_float(gg.y&0xffff0000u));
      ov.z=cvtpk_s(__uint_as_float(v.z<<16)*__uint_as_float(gg.z<<16),__uint_as_float(v.z&0xffff0000u)*__uint_as_float(gg.z&0xffff0000u)); ov.w=cvtpk_s(__uint_as_float(v.w<<16)*__uint_as_float(gg.w<<16),__uint_as_float(v.w&0xffff0000u)*__uint_as_float(gg.w&0xffff0000u));
      ATTN_STORE16(Ow+(long)row*DM+ch*8,ov);} }
  asm volatile("s_waitcnt lgkmcnt(0)\n\ts_barrier":::"memory");
  #undef DMA_K
  #undef DMA_V
  #undef CMASK
  #undef START
  #undef RESC
  #undef ROT
  #undef BIAS_OPS
  #undef BIAS_LD
}
constexpr int ATTN_LDS_BYTES=LDS_BYTES;
#undef SBAR
#undef WAIT_BAR
}

namespace att3 {
constexpr int L_SCR = RING_BYTES;
__device__ __forceinline__ s16x4 vtr(const LAS unsigned char* p) { typedef short v4i16_t __attribute__((ext_vector_type(4))); return __builtin_bit_cast(s16x4, __builtin_amdgcn_ds_read_tr16_b64_v4i16((LAS v4i16_t*)p)); }
__device__ __forceinline__ void glds16(const void* gsrc, unsigned lds_dst) { unsigned keep;
    asm volatile("s_mov_b32 %0, m0\n\ts_mov_b32 m0, %2\n\ts_nop 0\n\tglobal_load_lds_dwordx4 %1, off\n\ts_mov_b32 m0, %0" : "=&s"(keep) : "v"(gsrc), "s"(lds_dst) : "memory"); }
#define A3_MFMA(a, b, c) __builtin_amdgcn_mfma_f32_32x32x16_bf16(a, b, c, 0, 0, 0)
__device__ __forceinline__ void unit(LAS unsigned char* lds, unsigned lds0, const bf16* Qrows, const bf16* Grows, bf16* Orows, const float* Kc, const float* Vc, const bf16* Kn, const bf16* Vn, const float* F) {
    int tid_ = threadIdx.x; asm volatile("" : "+v"(tid_));
    const int tid = tid_, lane = tid & 63, r = lane & 31, hi = lane >> 5; const int w = __builtin_amdgcn_readfirstlane(tid >> 6);
    LAS unsigned char* buf = lds + w * 16384; const unsigned bufa = lds0 + (unsigned)w * 16384u;
    LAS float* scr = (LAS float*)(lds + L_SCR + w * 512);
    const float fref = F[(size_t)PAST * 16];
    bf16x8 qr[2][4];
#pragma unroll
    for (int qb = 0; qb < 2; ++qb)
#pragma unroll
        for (int d0 = 0; d0 < 4; ++d0) qr[qb][d0] = *(const bf16x8*)(Qrows + (size_t)(32 * qb + r) * DM + d0 * 16 + hi * 8);
    f32x16 o[2][2]; float mrun[2], lrun[2];
#pragma unroll
    for (int qb = 0; qb < 2; ++qb) { mrun[qb] = -1e30f; lrun[qb] = 0.f;
#pragma unroll
        for (int g = 0; g < 16; ++g) { o[qb][0][g] = 0.f; o[qb][1][g] = 0.f; } }
    const int vrow = lane >> 2, vcol = 8 * (lane & 3);
    for (int j = w; j <= PAST / 64; j += 8) {
        const bool isnew = j == PAST / 64;
        if (isnew) {
            const bf16* kp_ = Kn + (size_t)lane * DM; unsigned kd_ = bufa;
#pragma unroll 1
            for (int c = 0; c < 8; ++c) { glds16(kp_, (unsigned)__builtin_amdgcn_readfirstlane(kd_)); kp_ += 8; kd_ += 1024; }
            const bf16* vp_ = Vn + (size_t)vrow * DM + vcol;
#pragma unroll 1
            for (int pr = 0; pr < 4; ++pr) { glds16(vp_, (unsigned)__builtin_amdgcn_readfirstlane(kd_)); glds16(vp_ + 32, (unsigned)__builtin_amdgcn_readfirstlane(kd_ + 4096)); vp_ += (size_t)16 * DM; kd_ += 1024; }
        } else {
            const int rr = lane >> 2, q4 = lane & 3;
            const float* kf = Kc + ((size_t)64 * j + rr) * DM + 4 * q4; const float* vf_ = Vc + ((size_t)64 * j + rr) * DM + 4 * q4;
#pragma unroll
            for (int ih = 0; ih < 2; ++ih) {
                f32x4 kr[8], vr[8];
#pragma unroll
                for (int i2 = 0; i2 < 2; ++i2)
#pragma unroll
                    for (int jq = 0; jq < 4; ++jq) { const int i = 2 * ih + i2; kr[4 * i2 + jq] = *(const f32x4*)(kf + (size_t)16 * i * DM + 16 * jq); vr[4 * i2 + jq] = *(const f32x4*)(vf_ + (size_t)16 * i * DM + 16 * jq); }
#pragma unroll
                for (int i2 = 0; i2 < 2; ++i2)
#pragma unroll
                    for (int jq = 0; jq < 4; ++jq) { const f32x4 k4 = kr[4 * i2 + jq], v4 = vr[4 * i2 + jq]; const int row = 16 * (2 * ih + i2) + rr;
                        *(LAS v2u*)(buf + (2 * jq + (q4 >> 1)) * 1024 + row * 16 + (q4 & 1) * 8) = (v2u){pk_bf16(k4[0], k4[1]), pk_bf16(k4[2], k4[3])};
                        *(LAS v2u*)(buf + 8192 + (jq >> 1) * 4096 + row * 64 + (jq & 1) * 32 + q4 * 8) = (v2u){pk_bf16(v4[0], v4[1]), pk_bf16(v4[2], v4[3])}; }
            }
        }
        const float fkv = (fref - F[((size_t)64 * j + lane) * 16]) * LOG2E;
        scr[lane] = fkv;
        asm volatile("s_waitcnt vmcnt(0) lgkmcnt(0)" ::: "memory");
        __builtin_amdgcn_sched_barrier(0);
        bf16x8 ka[4], kb[4];
#pragma unroll
        for (int d0 = 0; d0 < 4; ++d0) { ka[d0] = *(const LAS bf16x8*)(buf + hi * 1024 + r * 16 + d0 * 2048); kb[d0] = *(const LAS bf16x8*)(buf + hi * 1024 + r * 16 + d0 * 2048 + 512); }
        const LAS unsigned char* vb = buf + 8192 + ((lane >> 4) & 1) * 32 + (lane & 3) * 8 + (4 * hi + ((lane & 15) >> 2)) * 64;
#pragma unroll
        for (int qb = 0; qb < 2; ++qb) {
            f32x16 p0, p1;
#pragma unroll
            for (int jj = 0; jj < 4; ++jj) { const f32x4 f0 = *(const LAS f32x4*)(scr + 8 * jj + 4 * hi), f1 = *(const LAS f32x4*)(scr + 32 + 8 * jj + 4 * hi);
#pragma unroll
                for (int i = 0; i < 4; ++i) { p0[4 * jj + i] = f0[i]; p1[4 * jj + i] = f1[i]; } }
#pragma unroll
            for (int d0 = 0; d0 < 4; ++d0) { p0 = A3_MFMA(ka[d0], qr[qb][d0], p0); p1 = A3_MFMA(kb[d0], qr[qb][d0], p1); }
            if (isnew) { const int qrel = 32 * qb + r;
#pragma unroll
                for (int g = 0; g < 16; ++g) { const int kv = crow(g, hi); if (kv > qrel) p0[g] = -__builtin_inff(); if (kv + 32 > qrel) p1[g] = -__builtin_inff(); } }
            float rm = fmaxf(p0[0], p1[0]);
#pragma unroll
            for (int g = 1; g < 16; ++g) rm = fmaxf(rm, fmaxf(p0[g], p1[g]));
            rm = fmaxf(rm, __shfl_xor(rm, 32));
            const float mnew = fmaxf(mrun[qb], rm), alpha = __builtin_amdgcn_exp2f(mrun[qb] - mnew); mrun[qb] = mnew;
            float ps = 0.f;
#pragma unroll
            for (int g = 0; g < 16; ++g) { p0[g] = __builtin_amdgcn_exp2f(p0[g] - mnew); p1[g] = __builtin_amdgcn_exp2f(p1[g] - mnew); ps += p0[g] + p1[g]; }
            lrun[qb] = lrun[qb] * alpha + ps;
            if (hi == 0) scr[64 + r] = alpha;
#pragma unroll
            for (int jj = 0; jj < 4; ++jj) { const f32x4 a4 = *(const LAS f32x4*)(scr + 64 + 8 * jj + 4 * hi);
#pragma unroll
                for (int i = 0; i < 4; ++i) { o[qb][0][4 * jj + i] *= a4[i]; o[qb][1][4 * jj + i] *= a4[i]; } }
            const v4u pw0 = (v4u){pk_bf16(p0[0], p0[1]), pk_bf16(p0[2], p0[3]), pk_bf16(p0[4], p0[5]), pk_bf16(p0[6], p0[7])};
            const v4u pw1 = (v4u){pk_bf16(p0[8], p0[9]), pk_bf16(p0[10], p0[11]), pk_bf16(p0[12], p0[13]), pk_bf16(p0[14], p0[15])};
            const v4u pw2 = (v4u){pk_bf16(p1[0], p1[1]), pk_bf16(p1[2], p1[3]), pk_bf16(p1[4], p1[5]), pk_bf16(p1[6], p1[7])};
            const v4u pw3 = (v4u){pk_bf16(p1[8], p1[9]), pk_bf16(p1[10], p1[11]), pk_bf16(p1[12], p1[13]), pk_bf16(p1[14], p1[15])};
#pragma unroll
            for (int d0 = 0; d0 < 2; ++d0) {
                bf16x8 vf[4];
#pragma unroll
                for (int ks = 0; ks < 4; ++ks) { const s16x4 lo = vtr(vb + d0 * 4096 + ks * 1024), hh = vtr(vb + d0 * 4096 + ks * 1024 + 512);
                    vf[ks] = (bf16x8){lo[0], lo[1], lo[2], lo[3], hh[0], hh[1], hh[2], hh[3]}; }
                o[qb][d0] = A3_MFMA(__builtin_bit_cast(bf16x8, pw0), vf[0], o[qb][d0]); o[qb][d0] = A3_MFMA(__builtin_bit_cast(bf16x8, pw1), vf[1], o[qb][d0]);
                o[qb][d0] = A3_MFMA(__builtin_bit_cast(bf16x8, pw2), vf[2], o[qb][d0]); o[qb][d0] = A3_MFMA(__builtin_bit_cast(bf16x8, pw3), vf[3], o[qb][d0]);
            }
        }
        asm volatile("s_waitcnt lgkmcnt(0)" ::: "memory");
        __builtin_amdgcn_sched_barrier(0);
    }
#pragma unroll
    for (int qb = 0; qb < 2; ++qb) {
        lrun[qb] += __shfl_xor(lrun[qb], 32);
#pragma unroll
        for (int g = 0; g < 16; ++g)
#pragma unroll
            for (int d0 = 0; d0 < 2; ++d0) *(LAS float*)(buf + (32 * qb + crow(g, hi)) * 256 + (32 * d0 + r) * 4) = o[qb][d0][g];
        if (hi == 0) { scr[32 * qb + r] = mrun[qb]; scr[64 + 32 * qb + r] = lrun[qb]; }
    }
    __syncthreads();
    {
        const int row = tid >> 3, dg = tid & 7; float mw[8], M_ = -1e30f;
#pragma unroll
        for (int ww = 0; ww < 8; ++ww) { mw[ww] = *(const LAS float*)(lds + L_SCR + ww * 512 + row * 4); M_ = fmaxf(M_, mw[ww]); }
        float Lsum = 0.f; f32x4 a0 = (f32x4){0.f, 0.f, 0.f, 0.f}, a1 = a0;
#pragma unroll
        for (int ww = 0; ww < 8; ++ww) { const float sc = __builtin_amdgcn_exp2f(mw[ww] - M_); Lsum += sc * *(const LAS float*)(lds + L_SCR + ww * 512 + 256 + row * 4);
            const f32x4 x0 = *(const LAS f32x4*)(lds + ww * 16384 + row * 256 + dg * 32), x1 = *(const LAS f32x4*)(lds + ww * 16384 + row * 256 + dg * 32 + 16);
            a0 += x0 * sc; a1 += x1 * sc; }
        const float rl = __builtin_amdgcn_rcpf(Lsum); const size_t go = (size_t)row * DM + 8 * dg; const v4u gg = *(const v4u*)(Grows + go);
        v4u ov; ov.x = pk_bf16(a0[0] * rl * bf_lo(gg.x), a0[1] * rl * bf_hi(gg.x)); ov.y = pk_bf16(a0[2] * rl * bf_lo(gg.y), a0[3] * rl * bf_hi(gg.y));
        ov.z = pk_bf16(a1[0] * rl * bf_lo(gg.z), a1[1] * rl * bf_hi(gg.z)); ov.w = pk_bf16(a1[2] * rl * bf_lo(gg.w), a1[3] * rl * bf_hi(gg.w));
        *(v4u*)(Orows + go) = ov;
    }
    __syncthreads();
}
#undef A3_MFMA
}

namespace sg {
enum { IN = 0, RES = 1, UP = 2, KVQ = 3 };
struct P {
    const bf16* A; const bf16* Bt; int K, N;
    const float* rss; int rss_parts;
    const float* lb;
    bf16* o0; float* rss_out; float* out;
};
constexpr int SG_STAGE = 24576, SG_NS = 4, SG_RED = SG_NS * SG_STAGE;
__device__ __forceinline__ void glds16(const void* gsrc, unsigned lds_dst) { unsigned keep;
    asm volatile("s_mov_b32 %0, m0\n\ts_mov_b32 m0, %2\n\ts_nop 0\n\tglobal_load_lds_dwordx4 %1, off\n\ts_mov_b32 m0, %0" : "=&s"(keep) : "v"(gsrc), "s"(lds_dst) : "memory"); }
template <int MODE> __device__ __forceinline__ void phase(LAS unsigned char* lds, unsigned lds0, const P& p, int vcu, int G) {
    const int tid = threadIdx.x, lane = tid & 63, r = lane & 31, hi = lane >> 5; const int w = __builtin_amdgcn_readfirstlane(tid >> 6);
    const int nh = w & 1, kq = w >> 1, nct = p.N >> 6, nblk = p.K >> 7, ntile = 16 * nct;
    LAS float* red = (LAS float*)(lds + SG_RED);
    if (vcu >= ntile) return;
    const int mytiles = (ntile - vcu + G - 1) / G, NB = mytiles * nblk;
    const int lr = lane >> 4, sl = lane & 15;
    const int arow = 4 * w + lr, brow0 = 4 * w + lr, brow1 = 32 + 4 * w + lr;
    const int acol = ((sl ^ (arow & 15)) << 3), bcol0 = ((sl ^ (brow0 & 15)) << 3), bcol1 = ((sl ^ (brow1 & 15)) << 3);
#define SG_DMA(n_) do { const int ti_ = (n_) / nblk, bk_ = (n_) - ti_ * nblk, tt_ = vcu + ti_ * G, rt_ = tt_ & 15, ct_ = tt_ >> 4; const unsigned st_ = lds0 + (unsigned)(((n_) & (SG_NS - 1)) * SG_STAGE); \
        glds16(p.A + (size_t)(MP + 32 * rt_ + arow) * p.K + bk_ * 128 + acol, (unsigned)__builtin_amdgcn_readfirstlane(st_ + w * 1024)); \
        glds16(p.Bt + (size_t)(64 * ct_ + brow0) * p.K + bk_ * 128 + bcol0, (unsigned)__builtin_amdgcn_readfirstlane(st_ + 8192 + w * 1024)); \
        glds16(p.Bt + (size_t)(64 * ct_ + brow1) * p.K + bk_ * 128 + bcol1, (unsigned)__builtin_amdgcn_readfirstlane(st_ + 16384 + w * 1024)); } while (0)
    SG_DMA(0); if (NB > 1) SG_DMA(1); if (NB > 2) SG_DMA(2);
    f32x16 acc;
#pragma unroll
    for (int g = 0; g < 16; ++g) acc[g] = 0.f;
    const int fa0 = r * 256 + (((4 * kq + hi) ^ (r & 15)) << 4), fa1 = r * 256 + (((4 * kq + 2 + hi) ^ (r & 15)) << 4);
    int n = 0, t = vcu;
    for (;;) {
        const int rt = t & 15, ct = t >> 4, row0 = MP + 32 * rt, col0 = 64 * ct;
        const int g0 = 2 * w, rowA = row0 + crow(g0, hi), rowB = row0 + crow(g0 + 1, hi), c0 = col0 + r, c1 = c0 + 32;
        float ssA = 0.f, ssB = 0.f; f32x4 pa[4], pb[4]; unsigned short xo[4];
        {
            if (MODE == RES) { const bf16* xa = p.o0 + (size_t)rowA * 1024; const bf16* xb = p.o0 + (size_t)rowB * 1024; xo[0] = xa[c0]; xo[1] = xa[c1]; xo[2] = xb[c0]; xo[3] = xb[c1]; }
            else if (p.rss_parts == 1) { ssA = p.rss[rowA]; ssB = p.rss[rowB]; }
            else { const f32x4* qa = (const f32x4*)(p.rss + (size_t)rowA * 16); const f32x4* qb = (const f32x4*)(p.rss + (size_t)rowB * 16);
#pragma unroll
                for (int q = 0; q < 4; ++q) { pa[q] = qa[q]; pb[q] = qb[q]; } }
        }
        for (int bk = 0; bk < nblk; ++bk, ++n) {
            if (n + 2 < NB) asm volatile("s_waitcnt vmcnt(6) lgkmcnt(0)\n\ts_barrier" ::: "memory");
            else if (n + 1 < NB) asm volatile("s_waitcnt vmcnt(3) lgkmcnt(0)\n\ts_barrier" ::: "memory");
            else asm volatile("s_waitcnt vmcnt(0) lgkmcnt(0)\n\ts_barrier" ::: "memory");
            if (n + 3 < NB) SG_DMA(n + 3);
            const LAS unsigned char* st = lds + (n & (SG_NS - 1)) * SG_STAGE;
            const bf16x8 a0 = *(const LAS bf16x8*)(st + fa0), a1 = *(const LAS bf16x8*)(st + fa1);
            const bf16x8 b0 = *(const LAS bf16x8*)(st + 8192 + nh * 8192 + fa0), b1 = *(const LAS bf16x8*)(st + 8192 + nh * 8192 + fa1);
            acc = __builtin_amdgcn_mfma_f32_32x32x16_bf16(a0, b0, acc, 0, 0, 0);
            acc = __builtin_amdgcn_mfma_f32_32x32x16_bf16(a1, b1, acc, 0, 0, 0);
        }
#pragma unroll
        for (int g = 0; g < 16; ++g) { red[(w * 16 + g) * 64 + lane] = acc[g]; acc[g] = 0.f; }
        asm volatile("s_waitcnt lgkmcnt(0)\n\ts_barrier" ::: "memory");
#pragma unroll
        for (int gi = 0; gi < 2; ++gi) {
            const int g = g0 + gi; float v0 = 0.f, v1 = 0.f;
#pragma unroll
            for (int q = 0; q < 4; ++q) { v0 += red[((2 * q) * 16 + g) * 64 + lane]; v1 += red[((2 * q + 1) * 16 + g) * 64 + lane]; }
            const int row = gi ? rowB : rowA;
            float rs = 1.f;
            if (MODE != RES) {
                float ss;
                if (p.rss_parts == 1) ss = gi ? ssB : ssA;
                else { const f32x4 a0 = gi ? pb[0] : pa[0], a1 = gi ? pb[1] : pa[1], a2 = gi ? pb[2] : pa[2], a3 = gi ? pb[3] : pa[3];
                    ss = (((a0[0] + a0[1]) + (a0[2] + a0[3])) + ((a1[0] + a1[1]) + (a1[2] + a1[3]))) + (((a2[0] + a2[1]) + (a2[2] + a2[3])) + ((a3[0] + a3[1]) + (a3[2] + a3[3]))); }
                rs = rsqrtf(ss * (1.0f / 1024.0f) + EPS);
            }
            const float z0 = v0 * rs, z1 = v1 * rs;
#define SG_ST(ptr, val) *(ptr) = (unsigned short)(pk_bf16((val), 0.f) & 0xffffu)
            if (MODE == IN) {
                const int seg = col0 >> 10, cc0 = c0 & 1023, cc1 = c1 & 1023; const size_t ro = (size_t)row * 1024;
                if (seg == 1) { const float l0 = p.lb[cc0], l1 = p.lb[cc1], s0 = sigmoidf_(z0), s1 = sigmoidf_(z1);
                    SG_ST(p.o0 + pg8::SLAB_ELEMS + ro + cc0, (1.f - l0) * (1.f - s0)); SG_ST(p.o0 + pg8::SLAB_ELEMS + ro + cc1, (1.f - l1) * (1.f - s1));
                    SG_ST(p.o0 + 2 * pg8::SLAB_ELEMS + ro + cc0, __logf(l0 + (1.f - l0) * s0)); SG_ST(p.o0 + 2 * pg8::SLAB_ELEMS + ro + cc1, __logf(l1 + (1.f - l1) * s1)); }
                else { bf16* o = p.o0 + (size_t)(seg == 0 ? 0 : seg == 2 ? 3 : 4) * pg8::SLAB_ELEMS + ro;
                    SG_ST(o + cc0, seg == 2 ? z0 : (seg == 0 ? z0 * sigmoidf_(z0) : sigmoidf_(z0))); SG_ST(o + cc1, seg == 2 ? z1 : (seg == 0 ? z1 * sigmoidf_(z1) : sigmoidf_(z1))); }
            } else if (MODE == RES) {
                bf16* xp = p.o0 + (size_t)row * 1024; const float x0 = bf2f(xo[2 * gi]) + v0, x1 = bf2f(xo[2 * gi + 1]) + v1;
                SG_ST(xp + c0, x0); SG_ST(xp + c1, x1);
                float sq = x0 * x0 + x1 * x1; sq += __shfl_xor(sq, 1); sq += __shfl_xor(sq, 2); sq += __shfl_xor(sq, 4); sq += __shfl_xor(sq, 8); sq += __shfl_xor(sq, 16);
                if (r == 0) p.rss_out[(size_t)row * 16 + ct] = sq;
            } else if (MODE == UP) {
                bf16* o = p.o0 + (size_t)row * 4096; const float h0 = fmaxf(z0, 0.f), h1 = fmaxf(z1, 0.f);
                SG_ST(o + c0, h0 * h0); SG_ST(o + c1, h1 * h1);
            } else {
                const int seg = col0 >> 10, cc0 = c0 & 1023, cc1 = c1 & 1023; const size_t ro = (size_t)row * 1024;
                bf16* o = p.o0 + (size_t)seg * pg8::SLAB_ELEMS + ro;
                if (seg < 2) { SG_ST(o + cc0, z0); SG_ST(o + cc1, z1); float* fo = p.out + (seg == 0 ? OK_S : OV_S) + (size_t)(row - MP) * 1024; fo[cc0] = z0; fo[cc1] = z1; }
                else if (seg == 2) { SG_ST(o + cc0, z0 * QSCALE); SG_ST(o + cc1, z1 * QSCALE); }
                else { SG_ST(o + cc0, sigmoidf_(z0)); SG_ST(o + cc1, sigmoidf_(z1)); }
            }
#undef SG_ST
        }
        asm volatile("s_waitcnt lgkmcnt(0)\n\ts_barrier" ::: "memory");
        t += G; if (t >= ntile) break;
    }
    __syncthreads();
#undef SG_DMA
}
}

constexpr int NWAVES = 8;
#ifndef MK_N_LAUNCHES
#define MK_N_LAUNCHES 1
#endif
constexpr int N_PHASES = 13;
constexpr int N_LAUNCHES = MK_N_LAUNCHES;

struct Args {
    const float* in[21]; float* out_; unsigned char* ws_; int ph_lo, ph_hi, dry_gla, pad;
};

__device__ __forceinline__ void p0_transpose_item(const float* W, int K, int ldw, int nblk, const float* gain, bf16* WT, int row_off, LAS float* scr, int item, int lane) {
    const int kb = item / nblk, nb = item % nblk, k0 = 64 * kb, n0 = 32 * nb;
    {
        const int rg = lane >> 3, c4 = lane & 7; f32x4 v[8]; float gs[8];
#pragma unroll
        for (int i = 0; i < 8; ++i) { const int kk = 8 * i + rg; v[i] = *(const f32x4*)(W + (size_t)(k0 + kk) * ldw + n0 + 4 * c4); gs[i] = gain ? gain[k0 + kk] : 1.0f; }
#pragma unroll
        for (int i = 0; i < 8; ++i) { const int kk = 8 * i + rg; LAS float* d = scr + kk * 33 + 4 * c4; d[0] = v[i][0] * gs[i]; d[1] = v[i][1] * gs[i]; d[2] = v[i][2] * gs[i]; d[3] = v[i][3] * gs[i]; }
    }
    LDS_WAIT(); asm volatile("" ::: "memory");
    const int c = lane & 7;
#pragma unroll
    for (int j = 0; j < 4; ++j) { const int n = (lane >> 3) + 8 * j; const LAS float* s = scr + (8 * c) * 33 + n;
        v4u o; o.x = pk_bf16(s[0 * 33], s[1 * 33]); o.y = pk_bf16(s[2 * 33], s[3 * 33]); o.z = pk_bf16(s[4 * 33], s[5 * 33]); o.w = pk_bf16(s[6 * 33], s[7 * 33]);
        *(v4u*)(WT + (size_t)(row_off + n0 + n) * K + k0 + 8 * c) = o; }
    LDS_WAIT(); asm volatile("" ::: "memory");
}

__global__ void __launch_bounds__(NWAVES * 64, 2) yoco_fwd(Args args) {
    extern __shared__ __attribute__((aligned(16))) unsigned char lds_raw[];
    LAS unsigned char* lds = (LAS unsigned char*)lds_raw;
    volatile LAS unsigned* MISC = (volatile LAS unsigned*)(lds + MISC_OFF);
    const int tid = threadIdx.x, lane = tid & 63; const int wave = __builtin_amdgcn_readfirstlane(tid >> 6);
    const int G = gridDim.x, bx = blockIdx.x;
    const int vcu = (G % 8 == 0) ? (bx % 8) * (G / 8) + bx / 8 : bx;
    const int gw = vcu * NWAVES + wave, NGW = G * NWAVES;
#define ws (args.ws_)
#define out (args.out_)
#define ctl ((gu32*)(args.ws_ + WS_CTL))
#define lbv ((float*)(ws + WS_LB))
#define Wlf_t ((bf16*)(ws + WS_WLF))
#define rssx ((float*)(ws + WS_RSSX))
#define rssA ((float*)(ws + WS_RSSA))
#define rssB ((float*)(ws + WS_RSSB))
#define Fs ((float*)(ws + WS_FS))
#define Win_t ((bf16*)(ws + WS_WIN))
#define Wo_t ((bf16*)(ws + WS_WO))
#define Wup0_t ((bf16*)(ws + WS_WUP0))
#define Wdn0_t ((bf16*)(ws + WS_WDN0))
#define Wkvq_t ((bf16*)(ws + WS_WKVQ))
#define Wob_t ((bf16*)(ws + WS_WOB))
#define Wup1_t ((bf16*)(ws + WS_WUP1))
#define Wdn1_t ((bf16*)(ws + WS_WDN1))
#define XB ((bf16*)(ws + WS_SLAB0))
#define S1 ((bf16*)(ws + WS_SLAB0 + SLAB))
#define S2 ((bf16*)(ws + WS_SLAB0 + 2 * SLAB))
#define S3 ((bf16*)(ws + WS_SLAB0 + 3 * SLAB))
#define S4 ((bf16*)(ws + WS_SLAB0 + 4 * SLAB))
#define S5 ((bf16*)(ws + WS_SLAB0 + 5 * SLAB))
    LAS float* tabs = (LAS float*)(lds + TAB_OFF);

    for (int u = tid; u < 64; u += NWAVES * 64) ((LAS unsigned*)(lds + MISC_OFF))[u] = 0u;
    __syncthreads();
    XcdBarrier bar; bar.bar = (unsigned*)(ctl + CW_BAR); bar.x = 0; bar.st = nullptr;
    if (N_LAUNCHES == 1) bar = xcd_barrier_post((unsigned*)(ctl + CW_BAR), MISC + 8);
#define GRID_BAR() do { if (N_LAUNCHES == 1) xcd_barrier(bar); } while (0)
    const int lo = args.ph_lo, hi_ph = args.ph_hi;
#ifndef PHASE_MASK
#define PHASE_MASK 0x1fff
#endif
#define IN(k) (((PHASE_MASK >> (k)) & 1) && lo <= (k) && (k) < hi_ph)
#define SEAM(k) do { if (IN(k) && IN((k) + 1)) GRID_BAR(); } while (0)

    if (IN(0)) {
        LAS float* scr = (LAS float*)(lds + wave * 16384);
        constexpr int I_IN = 16 * 128, I_O = 16 * 32;
        for (int it = gw; it < I_IN + I_O; it += NGW) {
            if (it < I_IN) p0_transpose_item(args.in[7], 1024, 4096, 128, args.in[6], Win_t, 0, scr, it, lane);
            else p0_transpose_item(args.in[10], 1024, 1024, 32, nullptr, Wo_t, 0, scr, it - I_IN, lane);
        }
        const int gt = gw * 64 + lane, NGT = NGW * 64;
        for (int c = gt; c < 1024; c += NGT) lbv[c] = 1.0f / (1.0f + __expf(args.in[8][1024 + c] - args.in[8][c]));
        for (int m0 = gw; m0 < M; m0 += 4 * NGW) {
            f32x4 v[4][4];
#pragma unroll
            for (int u = 0; u < 4; ++u) { const int m = m0 + u * NGW; if (m < M) { const f32x4* xr = (const f32x4*)(m < MP ? args.in[0] + (size_t)m * DM : args.in[1] + (size_t)(m - MP) * DM) + lane;
#pragma unroll
                for (int j = 0; j < 4; ++j) v[u][j] = xr[64 * j]; } }
#pragma unroll
            for (int u = 0; u < 4; ++u) { const int m = m0 + u * NGW; if (m < M) { float s = 0.f;
#pragma unroll
                for (int j = 0; j < 4; ++j) s += (v[u][j][0] * v[u][j][0] + v[u][j][1] * v[u][j][1]) + (v[u][j][2] * v[u][j][2] + v[u][j][3] * v[u][j][3]);
                s = wave_sum(s); if (lane == 0) rssx[m] = s;
                v2u* o8 = (v2u*)(XB + (size_t)m * DM) + lane;
#pragma unroll
                for (int j = 0; j < 4; ++j) o8[64 * j] = (v2u){pk_bf16(v[u][j][0], v[u][j][1]), pk_bf16(v[u][j][2], v[u][j][3])}; } }
        }
    }
    SEAM(0);
    if (IN(1)) {
        { sg::P sp{XB, Win_t, 1024, 4096, rssx, 1, lbv, S1, nullptr, out}; sg::phase<sg::IN>(lds, (unsigned)(uintptr_t)lds_raw, sp, vcu, G); }
        pg8::Gemm g{XB, Win_t, MP, 4096, 1024}; pg8::StaticOrder S; S.init(MP, 4096, G, bx);
        pg8::EpiIn E{rssx, lbv, S1};
        pg8::gemm_phase<pg8::EpiIn, pg8::StaticOrder, true, true>(lds, tabs, g, S, E);
    }
    SEAM(1);
    if (IN(2)) {
        if (bx >= 192) {
            LAS float* scr = (LAS float*)(lds + wave * 16384);
            constexpr int I_UP = 16 * 128, I_DN = 64 * 32, I_KV = 16 * 64, I_Q = 16 * 64, I_O = 16 * 32;
            constexpr int NITEMS = I_UP + I_DN + I_KV + I_Q + I_O + I_UP + I_DN;
            const int xw = (bx - 192) * NWAVES + wave, NXW = (G - 192) * NWAVES;
            for (int it = xw; it < NITEMS; it += NXW) {
                int r = it;
                if (r < I_UP) { p0_transpose_item(args.in[18], 1024, 4096, 128, args.in[17], Wup0_t, 0, scr, r, lane); continue; } r -= I_UP;
                if (r < I_DN) { p0_transpose_item(args.in[19], 4096, 1024, 32, nullptr, Wdn0_t, 0, scr, r, lane); continue; } r -= I_DN;
                if (r < I_KV) { p0_transpose_item(args.in[12], 1024, 2064, 64, args.in[11], Wkvq_t, 0, scr, r, lane); continue; } r -= I_KV;
                if (r < I_Q)  { p0_transpose_item(args.in[15], 1024, 2048, 64, args.in[14], Wkvq_t, 2048, scr, r, lane); continue; } r -= I_Q;
                if (r < I_O)  { p0_transpose_item(args.in[16], 1024, 1024, 32, nullptr, Wob_t, 0, scr, r, lane); continue; } r -= I_O;
                if (r < I_UP) { p0_transpose_item(args.in[18] + (size_t)1024 * 4096, 1024, 4096, 128, args.in[17] + 1024, Wup1_t, 0, scr, r, lane); continue; } r -= I_UP;
                p0_transpose_item(args.in[19] + (size_t)4096 * 1024, 4096, 1024, 32, nullptr, Wdn1_t, 0, scr, r, lane);
            }
            for (int e = xw * 64 + lane; e < 16 * 1024; e += NXW * 64) { const int n = e >> 10, k = e & 1023; Wlf_t[e] = (unsigned short)(pk_bf16(args.in[12][(size_t)k * 2064 + 2048 + n] * args.in[11][k], 0.f) & 0xffffu); }
        }
        for (int u = bx; u < 192; u += G) {
            const bool smp = u >= 128; const int b = smp ? (u - 128) >> 3 : u >> 3, h = u & 7;
            const float* s0 = smp ? args.in[2] + (size_t)(b * HA + h) * KA * KA : nullptr;
            float* sfin = out + (smp ? OST_S : OST_P) + (size_t)(b * HA + h) * KA * KA;
            gla::unit(lds, S1, args.dry_gla ? (bf16*)(ws + 470 * MiB) : S1, args.dry_gla ? 16383 : -1, S2, S3, S4, S5, args.in[9], smp ? MP + b * TS : b * TP, smp ? 1 : TP / CH, h, s0, sfin);
        }
    }
    SEAM(2);
    if (IN(3)) {
        { sg::P sp{S1, Wo_t, 1024, 1024, nullptr, 1, nullptr, XB, rssA, out}; sg::phase<sg::RES>(lds, (unsigned)(uintptr_t)lds_raw, sp, vcu, G); }
        pg8::Gemm g{S1, Wo_t, MP, 1024, 1024}; pg8::StaticOrder S; S.init(MP, 1024, G, bx);
        pg8::EpiRes E{XB, rssA};
        pg8::gemm_phase<pg8::EpiRes, pg8::StaticOrder, true, true>(lds, tabs, g, S, E);
    }
    SEAM(3);
    if (IN(4)) {
        { sg::P sp{XB, Wup0_t, 1024, 4096, rssA, 16, nullptr, S2, nullptr, out}; sg::phase<sg::UP>(lds, (unsigned)(uintptr_t)lds_raw, sp, vcu, G);
#ifdef PROBE_SG
          sg::phase<sg::UP>(lds, (unsigned)(uintptr_t)lds_raw, sp, vcu, G); sg::phase<sg::UP>(lds, (unsigned)(uintptr_t)lds_raw, sp, vcu, G); sg::phase<sg::UP>(lds, (unsigned)(uintptr_t)lds_raw, sp, vcu, G); sg::phase<sg::UP>(lds, (unsigned)(uintptr_t)lds_raw, sp, vcu, G);
#endif
        }
        pg8::Gemm g{XB, Wup0_t, MP, 4096, 1024}; pg8::StaticOrder S; S.init(MP, 4096, G, bx);
        pg8::EpiUp E{rssA, S2};
        pg8::gemm_phase<pg8::EpiUp, pg8::StaticOrder, true, true>(lds, tabs, g, S, E);
    }
    SEAM(4);
    if (IN(5)) {
        { sg::P sp{S2, Wdn0_t, 4096, 1024, nullptr, 1, nullptr, XB, rssB, out}; sg::phase<sg::RES>(lds, (unsigned)(uintptr_t)lds_raw, sp, vcu, G); }
        pg8::Gemm g{S2, Wdn0_t, MP, 1024, 4096}; pg8::StaticOrder S; S.init(MP, 1024, G, bx);
        pg8::EpiRes E{XB, rssB};
        pg8::gemm_phase<pg8::EpiRes, pg8::StaticOrder, true, true>(lds, tabs, g, S, E);
    }
    SEAM(5);
    if (IN(6)) {
        for (int rb = gw; rb < MP / 16; rb += NGW) {
            const int arow = 16 * rb + (lane & 15), kq = lane >> 4;
            const bf16* ap = XB + (size_t)arow * DM + 8 * kq; const bf16* bp = Wlf_t + (size_t)(lane & 15) * DM + 8 * kq;
            f32x4 acc = (f32x4){0.f, 0.f, 0.f, 0.f};
#pragma unroll 16
            for (int ks = 0; ks < 32; ++ks) { const bf16x8 a = *(const bf16x8*)(ap + 32 * ks), b = *(const bf16x8*)(bp + 32 * ks); acc = __builtin_amdgcn_mfma_f32_16x16x32_bf16(a, b, acc, 0, 0, 0); }
            const int col = lane & 15; const float bias = args.in[13][col];
#pragma unroll
            for (int i = 0; i < 4; ++i) { const int row = 16 * rb + 4 * kq + i;
                const f32x4* pp = (const f32x4*)(rssB + (size_t)row * 16); const f32x4 p0 = pp[0], p1 = pp[1], p2 = pp[2], p3 = pp[3];
                const float ss = (((p0[0] + p0[1]) + (p0[2] + p0[3])) + ((p1[0] + p1[1]) + (p1[2] + p1[3]))) + (((p2[0] + p2[1]) + (p2[2] + p2[3])) + ((p3[0] + p3[1]) + (p3[2] + p3[3])));
                const float z = acc[i] * rsqrtf(ss * (1.0f / 1024.0f) + EPS) + bias;
                out[OLF_P + (size_t)row * 16 + col] = z < 0.f ? z - log1pf(expf(z)) : -log1pf(expf(-z)); }
        }
        for (int d = gw; d < MS * HB; d += NGW) {
            const int row = MP + (d >> 4), col = d & 15;
            const v4u xa = *((const v4u*)(XB + (size_t)row * DM) + lane), xb = *((const v4u*)(XB + (size_t)row * DM) + 64 + lane);
            const v4u wa = *((const v4u*)(Wlf_t + (size_t)col * DM) + lane), wb = *((const v4u*)(Wlf_t + (size_t)col * DM) + 64 + lane);
            float s = bf_lo(xa.x) * bf_lo(wa.x) + bf_hi(xa.x) * bf_hi(wa.x) + bf_lo(xa.y) * bf_lo(wa.y) + bf_hi(xa.y) * bf_hi(wa.y) + bf_lo(xa.z) * bf_lo(wa.z) + bf_hi(xa.z) * bf_hi(wa.z) + bf_lo(xa.w) * bf_lo(wa.w) + bf_hi(xa.w) * bf_hi(wa.w)
                    + bf_lo(xb.x) * bf_lo(wb.x) + bf_hi(xb.x) * bf_hi(wb.x) + bf_lo(xb.y) * bf_lo(wb.y) + bf_hi(xb.y) * bf_hi(wb.y) + bf_lo(xb.z) * bf_lo(wb.z) + bf_hi(xb.z) * bf_hi(wb.z) + bf_lo(xb.w) * bf_lo(wb.w) + bf_hi(xb.w) * bf_hi(wb.w);
            s = wave_sum(s);
            float ssp = rssB[(size_t)row * 16 + (lane & 15)]; ssp += __shfl_xor(ssp, 1); ssp += __shfl_xor(ssp, 2); ssp += __shfl_xor(ssp, 4); ssp += __shfl_xor(ssp, 8);
            const float z = s * rsqrtf(ssp * (1.0f / 1024.0f) + EPS) + args.in[13][col];
            if (lane == 0) out[OLF_S + (size_t)(row - MP) * 16 + col] = z < 0.f ? z - log1pf(expf(z)) : -log1pf(expf(-z));
        }
        { sg::P sp{XB, Wkvq_t, 1024, 4096, rssB, 16, nullptr, S1, nullptr, out}; sg::phase<sg::KVQ>(lds, (unsigned)(uintptr_t)lds_raw, sp, vcu, G); }
        pg8::Gemm g{XB, Wkvq_t, MP, 4096, 1024}; pg8::StaticOrder S; S.init(MP, 4096, G, bx);
        pg8::EpiKvq E{rssB, S1, out, QSCALE};
        pg8::gemm_phase<pg8::EpiKvq, pg8::StaticOrder, true, true>(lds, tabs, g, S, E);
    }
    SEAM(6);
    if (IN(7)) {
        if (bx >= BP + BS) {
            const int NE = (G - (BP + BS)) * NWAVES * 64, e0 = (bx - (BP + BS)) * NWAVES * 64 + tid; constexpr int NV = MP * 128;
            for (int e = e0; e < 2 * NV; e += 8 * NE) { v4u xv[8];
#pragma unroll
                for (int u = 0; u < 8; ++u) { const int ee = e + u * NE; if (ee < 2 * NV) xv[u] = ((const v4u*)(ee < NV ? S1 : S2))[ee < NV ? ee : ee - NV]; }
#pragma unroll
                for (int u = 0; u < 8; ++u) { const int ee = e + u * NE; if (ee < 2 * NV) { const v4u x = xv[u]; f32x4* d = (f32x4*)(out + (ee < NV ? OK_P : OV_P)) + (size_t)(ee < NV ? ee : ee - NV) * 2;
                    d[0] = (f32x4){bf_lo(x.x), bf_hi(x.x), bf_lo(x.y), bf_hi(x.y)}; d[1] = (f32x4){bf_lo(x.z), bf_hi(x.z), bf_lo(x.w), bf_hi(x.w)}; } }
            }
        }
        LAS f32x4* segsum = (LAS f32x4*)lds;
        for (int task = bx; task < BP + BS; task += G) {
            const bool smp = task >= BP; const int b = smp ? task - BP : task, nitems = smp ? (SKV / 16) * 4 : (TP / 16) * 4;
#define P7_SRC(seg_, i_) (smp ? (16 * (seg_) + (i_) < PAST ? (const f32x4*)(args.in[5] + ((size_t)b * PAST + 16 * (seg_) + (i_)) * 16) : (const f32x4*)(out + OLF_S + (size_t)(b * TS + 16 * (seg_) + (i_) - PAST) * 16)) \
                              : (const f32x4*)(out + OLF_P + (size_t)(b * TP + 16 * (seg_) + (i_)) * 16))
            for (int it = tid; it < nitems; it += NWAVES * 64) { const int hg = it & 3, seg = it >> 2; f32x4 v[16];
#pragma unroll
                for (int i = 0; i < 16; ++i) v[i] = P7_SRC(seg, i)[hg];
                f32x4 s4 = v[0];
#pragma unroll
                for (int i = 1; i < 16; ++i) s4 += v[i];
                segsum[it] = s4; }
            __syncthreads();
            for (int it = tid; it < nitems; it += NWAVES * 64) { const int hg = it & 3, seg = it >> 2; f32x4 v[16];
#pragma unroll
                for (int i = 0; i < 16; ++i) v[i] = P7_SRC(seg, i)[hg];
                f32x4 run = (f32x4){0.f, 0.f, 0.f, 0.f};
                for (int q = 0; q < seg; ++q) run += segsum[q * 4 + hg];
                if (smp) { f32x4* dstF = (f32x4*)(Fs + ((size_t)b * SKV + 16 * seg) * 16) + hg;
#pragma unroll
                    for (int i = 0; i < 16; ++i) { run += v[i]; dstF[i * 4] = run; }
                } else {
                    f32x4 te = run;
                    for (int q = seg; q <= (seg | 3); ++q) te += segsum[q * 4 + hg];
#pragma unroll
                    for (int i = 0; i < 16; ++i) { run += v[i];
#pragma unroll
                        for (int k = 0; k < 4; ++k) { const float fr = (te[k] - run[k]) * LOG2E; const unsigned fh = pk_bf16(fr, 0.f) & 0xffffu;
                            ((unsigned*)(ws + WS_FKP))[(size_t)(b * HB + 4 * hg + k) * TP + 16 * seg + i] = fh | (pk_bf16(fr - __uint_as_float(fh << 16), 0.f) << 16); } }
                    if ((seg & 3) == 3) {
#pragma unroll
                        for (int k = 0; k < 4; ++k) ((float*)(ws + WS_CEND))[(b * HB + 4 * hg + k) * (TP / 64) + (seg >> 2)] = te[k] * LOG2E; }
                }
            }
#undef P7_SRC
            __syncthreads();
        }
    }
    SEAM(7);
    if (IN(8)) {
        volatile LAS int* qslot = (volatile LAS int*)(lds + MISC_OFF + 128);
        gu32* qhead = ctl + CW_ATT;
        if (tid == 0) qslot[0] = (int)__hip_atomic_fetch_add(qhead, 1u, RLX_AGENT);
        __syncthreads();
        int L = __builtin_amdgcn_readfirstlane(qslot[0]);
        while (L < 128 + 2048) {
            int pre = 0;
            if (tid == 0) pre = (int)__hip_atomic_fetch_add(qhead, 1u, RLX_AGENT);
            if (L < 128) { const int b = L >> 4, h = L & 15; const size_t qo = (size_t)(MP + b * TS) * DM + h * DH;
#ifndef NO_ATT3
                att3::unit(lds, (unsigned)(uintptr_t)lds_raw, S3 + qo, S4 + qo, S5 + qo, args.in[3] + (size_t)b * PAST * DM + h * DH, args.in[4] + (size_t)b * PAST * DM + h * DH, S1 + qo, S2 + qo, Fs + (size_t)b * SKV * 16 + h);
#endif
            } else { const int Lp = L - 128, qb = 7 - (Lp >> 8), b = (Lp >> 4) & 15, h = Lp & 15;
#ifndef NO_ATT2
                att2::attn_unit<8>(b, h, qb, S3, S1, S2, S4, S5, (const unsigned*)(ws + WS_FKP) + (size_t)(b * HB + h) * TP, (const float*)(ws + WS_CEND) + (b * HB + h) * (TP / 64), (char*)lds_raw);
#endif
            }
            if (tid == 0) qslot[0] = pre;
            __syncthreads();
            L = __builtin_amdgcn_readfirstlane(qslot[0]);
            __syncthreads();
        }
    }
    SEAM(8);
    if (IN(9)) {
        { sg::P sp{S5, Wob_t, 1024, 1024, nullptr, 1, nullptr, XB, rssA, out}; sg::phase<sg::RES>(lds, (unsigned)(uintptr_t)lds_raw, sp, vcu, G); }
        pg8::Gemm g{S5, Wob_t, MP, 1024, 1024}; pg8::StaticOrder S; S.init(MP, 1024, G, bx);
        pg8::EpiRes E{XB, rssA};
        pg8::gemm_phase<pg8::EpiRes, pg8::StaticOrder, true, true>(lds, tabs, g, S, E);
    }
    SEAM(9);
    if (IN(10)) {
        { sg::P sp{XB, Wup1_t, 1024, 4096, rssA, 16, nullptr, S1, nullptr, out}; sg::phase<sg::UP>(lds, (unsigned)(uintptr_t)lds_raw, sp, vcu, G); }
        pg8::Gemm g{XB, Wup1_t, MP, 4096, 1024}; pg8::StaticOrder S; S.init(MP, 4096, G, bx);
        pg8::EpiUp E{rssA, S1};
        pg8::gemm_phase<pg8::EpiUp, pg8::StaticOrder, true, true>(lds, tabs, g, S, E);
    }
    SEAM(10);
    if (IN(11)) {
        { sg::P sp{S1, Wdn1_t, 4096, 1024, nullptr, 1, nullptr, XB, rssB, out}; sg::phase<sg::RES>(lds, (unsigned)(uintptr_t)lds_raw, sp, vcu, G); }
        pg8::Gemm g{S1, Wdn1_t, MP, 1024, 4096}; pg8::StaticOrder S; S.init(MP, 1024, G, bx);
        pg8::EpiRes E{XB, rssB};
        pg8::gemm_phase<pg8::EpiRes, pg8::StaticOrder, true, true>(lds, tabs, g, S, E);
    }
    SEAM(11);
    if (IN(12)) {
        f32x4 gfv[4];
#pragma unroll
        for (int j = 0; j < 4; ++j) gfv[j] = ((const f32x4*)args.in[20])[64 * j + lane];
        for (int m0 = gw; m0 < M; m0 += 4 * NGW) {
            v2u xv[4][4]; float ps[4];
#pragma unroll
            for (int u = 0; u < 4; ++u) { const int m = m0 + u * NGW; if (m < M) { ps[u] = rssB[(size_t)m * 16 + (lane & 15)]; const v2u* xr = (const v2u*)(XB + (size_t)m * DM) + lane;
#pragma unroll
                for (int j = 0; j < 4; ++j) xv[u][j] = xr[64 * j]; } }
#pragma unroll
            for (int u = 0; u < 4; ++u) { const int m = m0 + u * NGW; if (m < M) { float p_ = ps[u]; p_ += __shfl_xor(p_, 1); p_ += __shfl_xor(p_, 2); p_ += __shfl_xor(p_, 4); p_ += __shfl_xor(p_, 8);
                const float rs = rsqrtf(p_ * (1.0f / 1024.0f) + EPS);
                f32x4* yo = (f32x4*)(m < MP ? out + OY_P + (size_t)m * DM : out + OY_S + (size_t)(m - MP) * DM) + lane;
#pragma unroll
                for (int j = 0; j < 4; ++j) { const v2u x = xv[u][j]; const f32x4 gg = gfv[j];
                    yo[64 * j] = (f32x4){bf_lo(x.x) * rs * gg[0], bf_hi(x.x) * rs * gg[1], bf_lo(x.y) * rs * gg[2], bf_hi(x.y) * rs * gg[3]}; } } }
        }
    }
#undef IN
#undef SEAM
#undef GRID_BAR
#undef ws
#undef out
#undef ctl
#undef lbv
#undef Wlf_t
#undef rssx
#undef rssA
#undef rssB
#undef Fs
#undef Win_t
#undef Wo_t
#undef Wup0_t
#undef Wdn0_t
#undef Wkvq_t
#undef Wob_t
#undef Wup1_t
#undef Wdn1_t
#undef XB
#undef S1
#undef S2
#undef S3
#undef S4
#undef S5
}

extern "C" void kernel_launch(void* const* d_in, const int* in_sizes, int n_in, void* d_out, int out_size, void* d_ws, size_t ws_size, hipStream_t stream) {
    static int grid = 0;
    if (grid == 0) {
        if (n_in != 21 || (size_t)out_size != OUT_END || ws_size < WS_END) { fprintf(stderr, "kernel_launch: unexpected shapes: n_in %d out %d ws %zu (need %zu)\n", n_in, out_size, ws_size, (size_t)WS_END); grid = -1; return; }
        int dev = 0, cus = 0, per_cu = 0;
        if (hipGetDevice(&dev) != hipSuccess || hipDeviceGetAttribute(&cus, hipDeviceAttributeMultiprocessorCount, dev) != hipSuccess) { grid = -1; return; }
        if (hipFuncSetAttribute((const void*)yoco_fwd, hipFuncAttributeMaxDynamicSharedMemorySize, LDS_BYTES) != hipSuccess) { fprintf(stderr, "kernel_launch: hipFuncSetAttribute failed\n"); grid = -1; return; }
        if (hipOccupancyMaxActiveBlocksPerMultiprocessor(&per_cu, (const void*)yoco_fwd, NWAVES * 64, LDS_BYTES) != hipSuccess || per_cu < 1) { fprintf(stderr, "kernel_launch: occupancy query reports %d blocks per CU\n", per_cu); }
        (void)hipGetLastError();
        grid = cus;
        fprintf(stderr, "kernel_launch: grid %d, occupancy %d per CU, ws %zu\n", grid, per_cu, ws_size);
    }
    if (grid < 0) return;
    if (hipMemsetAsync((char*)d_ws + WS_CTL, 0, CTL_ZERO_BYTES, stream) != hipSuccess) { fprintf(stderr, "kernel_launch: memset failed\n"); return; }
    Args a{};
    for (int i = 0; i < 21; ++i) a.in[i] = (const float*)d_in[i];
    a.out_ = (float*)d_out; a.ws_ = (unsigned char*)d_ws;
#ifndef PROBE_SPLIT
#define PROBE_SPLIT -1
#endif
    if (PROBE_SPLIT >= 0) {
        a.ph_lo = 0; a.ph_hi = PROBE_SPLIT + 1; a.dry_gla = (PROBE_SPLIT == 2); hipLaunchKernelGGL(yoco_fwd, dim3(grid), dim3(NWAVES * 64), LDS_BYTES, stream, a);
        (void)hipMemsetAsync((char*)d_ws + WS_CTL, 0, CTL_ZERO_BYTES, stream);
        a.ph_lo = PROBE_SPLIT; a.ph_hi = N_PHASES; a.dry_gla = 0; hipLaunchKernelGGL(yoco_fwd, dim3(grid), dim3(NWAVES * 64), LDS_BYTES, stream, a);
    } else if (N_LAUNCHES == 1) { a.ph_lo = 0; a.ph_hi = N_PHASES; hipLaunchKernelGGL(yoco_fwd, dim3(grid), dim3(NWAVES * 64), LDS_BYTES, stream, a); }
    else for (int p = 0; p < N_PHASES; ++p) { a.ph_lo = p; a.ph_hi = p + 1; hipLaunchKernelGGL(yoco_fwd, dim3(grid), dim3(NWAVES * 64), LDS_BYTES, stream, a); }
    const hipError_t le = hipPeekAtLastError();
    if (le != hipSuccess) fprintf(stderr, "kernel_launch: launch failed: %s\n", hipGetErrorName(le));
}
```

```cpp
#include <hip/hip_runtime.h>
#include <cstdio>
#include <cstdint>

constexpr int DM = 1024, FF = 4096;
constexpr int BP = 16, TP = 2048, BS = 8, TS = 64, PAST = 4096;
constexpr int MP = BP * TP, MS = BS * TS, M = MP + MS;
constexpr int HA = 8, KA = 128, HB = 16, DH = 64, CH = 64;
constexpr int SKV = PAST + TS;
constexpr float EPS = 1e-6f;
constexpr float LOG2E = 1.4426950408889634f;
constexpr float QSCALE = 0.125f * LOG2E;

constexpr size_t OY_P = 0, OY_S = 33554432, OST_P = 34078720, OK_P = 36175872, OV_P = 69730304, OLF_P = 103284736,
                 OST_S = 103809024, OK_S = 104857600, OV_S = 105381888, OLF_S = 105906176, OUT_END = 105914368;

constexpr size_t MiB = 1u << 20;
constexpr size_t WS_CTL = 0, CTL_ZERO_BYTES = 32768;
constexpr size_t WS_LB = 1 * MiB;
constexpr size_t WS_WLF = 1 * MiB + 65536;
constexpr size_t WS_RSSX = 2 * MiB;
constexpr size_t WS_RSSA = 3 * MiB, WS_RSSB = 6 * MiB;
constexpr size_t WS_FS = 11 * MiB;
constexpr size_t WS_WIN = 14 * MiB, WS_WO = 22 * MiB, WS_WUP0 = 24 * MiB, WS_WDN0 = 32 * MiB, WS_WKVQ = 40 * MiB, WS_WOB = 48 * MiB, WS_WUP1 = 50 * MiB, WS_WDN1 = 58 * MiB;
constexpr size_t SLAB = (size_t)M * DM * 2;
constexpr size_t WS_SLAB0 = 66 * MiB;
constexpr size_t WS_END = WS_SLAB0 + 6 * SLAB;
static_assert(SLAB == 65 * MiB && WS_END <= 512 * MiB, "workspace map");
constexpr size_t WS_FKP = 460 * MiB, WS_CEND = 462 * MiB;
constexpr int CW_BAR = 4096, CW_ATT = 64;

constexpr int RING_BYTES = 131072;
constexpr int TAB_OFF = RING_BYTES;
constexpr int LDS_BYTES = 147456;
constexpr int MISC_OFF = LDS_BYTES - 256;

#define GAS __attribute__((address_space(1)))
#define LAS __attribute__((address_space(3)))
typedef unsigned short bf16;
typedef unsigned v4u __attribute__((ext_vector_type(4)));
typedef unsigned v2u __attribute__((ext_vector_type(2)));
typedef float f32x4 __attribute__((ext_vector_type(4)));
typedef float f32x16 __attribute__((ext_vector_type(16)));
typedef short bf16x8 __attribute__((ext_vector_type(8)));
typedef short s16x4 __attribute__((ext_vector_type(4)));
typedef GAS unsigned gu32;
#define RLX_AGENT __ATOMIC_RELAXED, __HIP_MEMORY_SCOPE_AGENT
#define LDS_WAIT() asm volatile("s_waitcnt lgkmcnt(0)" ::: "memory")
#define VM_WAIT() asm volatile("s_waitcnt vmcnt(0)" ::: "memory")

typedef float f32x2_c __attribute__((ext_vector_type(2))); typedef __bf16 bf16x2_c __attribute__((ext_vector_type(2)));
__device__ __forceinline__ unsigned pk_bf16(float lo, float hi) { const f32x2_c v = {lo, hi}; return __builtin_bit_cast(unsigned, __builtin_convertvector(v, bf16x2_c)); }
__device__ __forceinline__ float bf_lo(unsigned u) { return __uint_as_float(u << 16); }
__device__ __forceinline__ float bf_hi(unsigned u) { return __uint_as_float(u & 0xffff0000u); }
__device__ __forceinline__ float bf2f(unsigned short u) { return __uint_as_float((unsigned)u << 16); }
__device__ __forceinline__ float sigmoidf_(float z) { return __builtin_amdgcn_rcpf(1.0f + __expf(-z)); }
__device__ __forceinline__ int crow(int r, int hi) { return (r & 3) + 8 * (r >> 2) + 4 * hi; }
__device__ __forceinline__ float wave_sum(float v) {
#pragma unroll
    for (int o = 1; o < 64; o <<= 1) v += __shfl_xor(v, o);
    return v;
}
namespace pg8 {
#define PG8_LAS __attribute__((address_space(3)))
typedef unsigned short bf16_t;
typedef short bf16x8 __attribute__((ext_vector_type(8)));
typedef float f32x4 __attribute__((ext_vector_type(4)));
typedef unsigned u32x4 __attribute__((ext_vector_type(4)));
constexpr int BM = 256, BK = 64, HALF = 128, HTB = HALF * BK * 2  , STAGE_BYTES = 8 * HTB, NXCD = 8, WGM = 8;

__host__ __device__ __forceinline__ int lds_byte(int r, int c) { const int st = (r >> 4) * 2 + (c >> 5), rr = r & 15, cc = c & 31, ob = rr * 64 + cc * 2; return st * 1024 + (ob ^ (((ob >> 9) & 1) << 5)); }
__host__ __device__ __forceinline__ void stage_rc(int b, int& R, int& C) { const int st = b / 1024, sb = b % 1024, swz = sb ^ (((sb >> 9) & 1) << 5); R = (st >> 1) * 16 + swz / 64; C = (st & 1) * 32 + (swz % 64) / 2; }
__host__ __device__ __forceinline__ int perm32(int rho) { const int n = rho >> 4, i = rho & 15; return 8 * (i >> 2) + 4 * n + (i & 3); }

struct Unit { int pm, pn; };
struct Gemm { const bf16_t* A; const bf16_t* Bt; int M, N, K; };

struct StaticOrder {
    int nM, nN, nwg, G, c;
    __host__ __device__ void init(int M, int N, int G_, int c_) { nM = M / BM; nN = N / BM; nwg = nM * nN; G = G_; c = c_; }
    __host__ __device__ bool next(int i, Unit& u) const {
        const long L = (long)i * G + c; if (L >= nwg) return false;
        int wgid = (int)L; { const int q = nwg / NXCD, r = nwg % NXCD, xcd = wgid % NXCD, off = wgid / NXCD; wgid = (xcd < r ? xcd * (q + 1) : r * (q + 1) + (xcd - r) * q) + off; }
        const int nig = WGM * nN, gid = wgid / nig, fm = gid * WGM, gsz = (nM - fm) < WGM ? (nM - fm) : WGM;
        u.pm = fm + ((wgid % nig) % gsz); u.pn = (wgid % nig) / gsz; return true;
    }
    __device__ __forceinline__ void a_ready(const Unit&) const {}
    __device__ __forceinline__ void done(const Unit&) const {}
};


constexpr size_t SLAB_ELEMS = (size_t)33280 * 1024;
__device__ __forceinline__ unsigned cvt_pk_bf16(float lo, float hi) { return pk_bf16(lo, hi); }
__device__ __forceinline__ float sigm(float z) { return __builtin_amdgcn_rcpf(1.0f + __expf(-z)); }
__device__ __forceinline__ void rs_from_full(PG8_LAS float* tab, const float* rss, int pm) {
    const int tid = threadIdx.x; if (tid < 256) tab[tid] = rsqrtf(rss[pm * 256 + tid] * (1.0f / 1024.0f) + 1e-6f);
}
__device__ __forceinline__ void rs_from_parts(PG8_LAS float* tab, const float* rss16, int pm) {
    const int tid = threadIdx.x, row = tid >> 1, hf = tid & 1;
    const f32x4* p = (const f32x4*)(rss16 + (size_t)(pm * 256 + row) * 16 + hf * 8); const f32x4 a = p[0], b = p[1];
    float s = ((a.x + a.y) + (a.z + a.w)) + ((b.x + b.y) + (b.z + b.w)); s += __shfl_xor(s, 1);
    if (!hf) tab[row] = rsqrtf(s * (1.0f / 1024.0f) + 1e-6f);
}
#define PG8_PACK8(v0, v1) ((u32x4){cvt_pk_bf16((v0)[0], (v0)[1]), cvt_pk_bf16((v0)[2], (v0)[3]), cvt_pk_bf16((v1)[0], (v1)[1]), cvt_pk_bf16((v1)[2], (v1)[3])})

struct EpiIn {
    static constexpr bool PERM = true, AFTER_DRAIN = false;
    const float* rss; const float* lb; bf16_t* slab1;
    __device__ __forceinline__ void prep(PG8_LAS float* tab, const Unit& u) const { rs_from_full(tab, rss, u.pm); }
    __device__ __forceinline__ void operator()(const f32x4 (&acc)[2][2][4][2], const Unit& u, int wr, int wc, int fr, int fq, const PG8_LAS float* rst) const {
        const int seg = u.pn >> 2, colt = (u.pn & 3) * BM + wc * 32 + 8 * fq;
        const int row0 = u.pm * BM + wr * 64 + fr;
        if (seg == 1) {
            f32x4 lbv[2][2];
#pragma unroll
            for (int bj = 0; bj < 2; ++bj)
#pragma unroll
                for (int n = 0; n < 2; ++n) lbv[bj][n] = *(const f32x4*)(lb + colt + bj * HALF + 4 * n);
            bf16_t* okk = slab1 + SLAB_ELEMS; bf16_t* olf = slab1 + 2 * SLAB_ELEMS;
#pragma unroll
            for (int ai = 0; ai < 2; ++ai)
#pragma unroll
                for (int m = 0; m < 4; ++m) { const float rs = rst[ai * HALF + wr * 64 + m * 16 + fr]; const size_t ro = (size_t)(row0 + ai * HALF + m * 16) * 1024 + colt;
#pragma unroll
                    for (int bj = 0; bj < 2; ++bj) { f32x4 kk[2], lf[2];
#pragma unroll
                        for (int n = 0; n < 2; ++n)
#pragma unroll
                            for (int j = 0; j < 4; ++j) { const float z = acc[ai][bj][m][n][j] * rs, l = lbv[bj][n][j], sg = sigm(z), om = 1.0f - l;
                                kk[n][j] = om * (1.0f - sg); lf[n][j] = __logf(l + om * sg); }
                        *(u32x4*)(okk + ro + bj * HALF) = PG8_PACK8(kk[0], kk[1]); *(u32x4*)(olf + ro + bj * HALF) = PG8_PACK8(lf[0], lf[1]); } }
        } else {
            bf16_t* o = slab1 + (size_t)(seg == 0 ? 0 : seg == 2 ? 3 : 4) * SLAB_ELEMS;
#pragma unroll
            for (int ai = 0; ai < 2; ++ai)
#pragma unroll
                for (int m = 0; m < 4; ++m) { const float rs = rst[ai * HALF + wr * 64 + m * 16 + fr]; const size_t ro = (size_t)(row0 + ai * HALF + m * 16) * 1024 + colt;
#pragma unroll
                    for (int bj = 0; bj < 2; ++bj) { f32x4 v[2];
#pragma unroll
                        for (int n = 0; n < 2; ++n)
#pragma unroll
                            for (int j = 0; j < 4; ++j) { const float z = acc[ai][bj][m][n][j] * rs; v[n][j] = seg == 2 ? z : (seg == 0 ? z * sigm(z) : sigm(z)); }
                        *(u32x4*)(o + ro + bj * HALF) = PG8_PACK8(v[0], v[1]); } }
        }
    }
};
struct EpiRes {
    static constexpr bool PERM = true, AFTER_DRAIN = false;
    bf16_t* XB; float* rss_out;
    __device__ __forceinline__ void prep(PG8_LAS float*, const Unit&) const {}
    __device__ __forceinline__ void operator()(const f32x4 (&acc)[2][2][4][2], const Unit& u, int wr, int wc, int fr, int fq, const PG8_LAS float*) const {
        const int row0 = u.pm * BM + wr * 64 + fr, col0 = u.pn * BM + wc * 32 + 8 * fq;
#pragma unroll
        for (int ai = 0; ai < 2; ++ai)
#pragma unroll
            for (int m = 0; m < 4; ++m) { const int row = row0 + ai * HALF + m * 16; bf16_t* rowp = XB + (size_t)row * 1024 + col0; float s = 0.f;
#pragma unroll
                for (int bj = 0; bj < 2; ++bj) { const u32x4 old = *(const u32x4*)(rowp + bj * HALF); f32x4 v0 = acc[ai][bj][m][0], v1 = acc[ai][bj][m][1];
                    v0[0] += __uint_as_float(old.x << 16); v0[1] += __uint_as_float(old.x & 0xffff0000u); v0[2] += __uint_as_float(old.y << 16); v0[3] += __uint_as_float(old.y & 0xffff0000u);
                    v1[0] += __uint_as_float(old.z << 16); v1[1] += __uint_as_float(old.z & 0xffff0000u); v1[2] += __uint_as_float(old.w << 16); v1[3] += __uint_as_float(old.w & 0xffff0000u);
                    s += (v0[0] * v0[0] + v0[1] * v0[1]) + (v0[2] * v0[2] + v0[3] * v0[3]) + (v1[0] * v1[0] + v1[1] * v1[1]) + (v1[2] * v1[2] + v1[3] * v1[3]);
                    *(u32x4*)(rowp + bj * HALF) = PG8_PACK8(v0, v1); }
                s += __shfl_xor(s, 16); s += __shfl_xor(s, 32);
                if (fq == 0) rss_out[(size_t)row * 16 + u.pn * 4 + wc] = s; }
    }
};
struct EpiUp {
    static constexpr bool PERM = true, AFTER_DRAIN = false;
    const float* rss16; bf16_t* H;
    __device__ __forceinline__ void prep(PG8_LAS float* tab, const Unit& u) const { rs_from_parts(tab, rss16, u.pm); }
    __device__ __forceinline__ void operator()(const f32x4 (&acc)[2][2][4][2], const Unit& u, int wr, int wc, int fr, int fq, const PG8_LAS float* rst) const {
        const int row0 = u.pm * BM + wr * 64 + fr, col0 = u.pn * BM + wc * 32 + 8 * fq;
#pragma unroll
        for (int ai = 0; ai < 2; ++ai)
#pragma unroll
            for (int m = 0; m < 4; ++m) { const float rs = rst[ai * HALF + wr * 64 + m * 16 + fr]; bf16_t* rowp = H + (size_t)(row0 + ai * HALF + m * 16) * 4096 + col0;
#pragma unroll
                for (int bj = 0; bj < 2; ++bj) { f32x4 v[2];
#pragma unroll
                    for (int n = 0; n < 2; ++n)
#pragma unroll
                        for (int j = 0; j < 4; ++j) { const float z = fmaxf(acc[ai][bj][m][n][j] * rs, 0.f); v[n][j] = z * z; }
                    *(u32x4*)(rowp + bj * HALF) = PG8_PACK8(v[0], v[1]); } }
    }
};
struct EpiKvq {
    static constexpr bool PERM = true, AFTER_DRAIN = false;
    const float* rss16; bf16_t* slab1; float* out; float qscale;
    __device__ __forceinline__ void prep(PG8_LAS float* tab, const Unit& u) const { rs_from_parts(tab, rss16, u.pm); }
    __device__ __forceinline__ void operator()(const f32x4 (&acc)[2][2][4][2], const Unit& u, int wr, int wc, int fr, int fq, const PG8_LAS float* rst) const {
        const int seg = u.pn >> 2, colt = (u.pn & 3) * BM + wc * 32 + 8 * fq;
        const int row0 = u.pm * BM + wr * 64 + fr;
        bf16_t* o = slab1 + (size_t)seg * SLAB_ELEMS;
#pragma unroll
        for (int ai = 0; ai < 2; ++ai)
#pragma unroll
            for (int m = 0; m < 4; ++m) { const float rs = rst[ai * HALF + wr * 64 + m * 16 + fr]; const size_t ro = (size_t)(row0 + ai * HALF + m * 16) * 1024 + colt;
#pragma unroll
                for (int bj = 0; bj < 2; ++bj) { f32x4 v[2];
#pragma unroll
                    for (int n = 0; n < 2; ++n)
#pragma unroll
                        for (int j = 0; j < 4; ++j) { const float z = acc[ai][bj][m][n][j] * rs; v[n][j] = seg == 2 ? z * qscale : (seg == 3 ? sigm(z) : z); }
                    *(u32x4*)(o + ro + bj * HALF) = PG8_PACK8(v[0], v[1]); } }
    }
};

template <class Epi, class Sched, bool ALIGN_EPI = false, bool SP2 = false>
__device__ __forceinline__ void gemm_phase(PG8_LAS unsigned char* lds, PG8_LAS float* tabs, const Gemm g, const Sched& S, const Epi& E) {
    const int tid = threadIdx.x, wid = __builtin_amdgcn_readfirstlane(tid >> 6), lane = tid & 63, wr = wid >> 2, wc = wid & 3, fr = lane & 15, fq = lane >> 4;
    const int K = g.K, nt = K / BK;
    unsigned voffA[2], voffB[2];
#pragma unroll
    for (int i = 0; i < 2; ++i) { int R, C; stage_rc(tid * 16 + i * 8192, R, C); const int Rb = Epi::PERM ? ((R & ~31) + perm32(R & 31)) : R;
        voffA[i] = (unsigned)(R * K + C) * 2u; voffB[i] = (unsigned)(Rb * K + C) * 2u; }
    const size_t kstep = (size_t)(BK * 2);
    const size_t hstep = (size_t)HALF * K * 2;
    const size_t tstep = 2 * hstep;
    const unsigned ldsw = (unsigned)wid * 1024u;
    const int aoff = lds_byte(wr * 64 + fr, fq * 8), boff = lds_byte(wc * 32 + fr, fq * 8);
#define PG8_SA(b, h) (((b) * 2 + (h)) * HTB)
#define PG8_SB(b, h) ((4 + (b) * 2 + (h)) * HTB)
#define PG8_STAGE(bufoff, gbase, voff) do { _Pragma("unroll") for (int _i = 0; _i < 2; ++_i) \
        __builtin_amdgcn_global_load_lds((const unsigned*)((const char*)(gbase) + (voff)[_i]), (PG8_LAS unsigned*)(lds + (bufoff) + ldsw + _i * 8192), 16, 0, 0); } while (0)
#define PG8_LDA(dst, b, h) do { _Pragma("unroll") for (int m = 0; m < 4; ++m) _Pragma("unroll") for (int k = 0; k < 2; ++k) dst[m][k] = *(const PG8_LAS bf16x8*)(lds + PG8_SA(b, h) + aoff + m * 2048 + k * 1024); } while (0)
#define PG8_LDB(dst, b, h) do { _Pragma("unroll") for (int n = 0; n < 2; ++n) _Pragma("unroll") for (int k = 0; k < 2; ++k) dst[n][k] = *(const PG8_LAS bf16x8*)(lds + PG8_SB(b, h) + boff + n * 2048 + k * 1024); } while (0)
#define PG8_MMA(ai, bj, At, Bt) do { __builtin_amdgcn_s_setprio(1); _Pragma("unroll") for (int m = 0; m < 4; ++m) _Pragma("unroll") for (int n = 0; n < 2; ++n) _Pragma("unroll") for (int k = 0; k < 2; ++k) \
        acc[ai][bj][m][n] = __builtin_amdgcn_mfma_f32_16x16x32_bf16(Bt[n][k], At[m][k], acc[ai][bj][m][n], 0, 0, 0); __builtin_amdgcn_s_setprio(0); } while (0)
#define PG8_WAIT_V(n) asm volatile("s_waitcnt vmcnt(" #n ")" ::: "memory")
#define PG8_WAIT_L(n) asm volatile("s_waitcnt lgkmcnt(" #n ")" ::: "memory")
#define PG8_BAR __builtin_amdgcn_s_barrier()
#define PG8_SCHED __builtin_amdgcn_sched_barrier(0)
    Unit cur, nxt; int ui = 0;
    if (!S.next(0, cur)) return;
    f32x4 acc[2][2][4][2];
#pragma unroll
    for (int a = 0; a < 2; ++a)
#pragma unroll
        for (int b = 0; b < 2; ++b)
#pragma unroll
            for (int m = 0; m < 4; ++m)
#pragma unroll
                for (int n = 0; n < 2; ++n) acc[a][b][m][n] = (f32x4){0.f, 0.f, 0.f, 0.f};
    bf16x8 At[4][2], B0[2][2], B1[2][2];
    const char* cA = (const char*)g.A + (size_t)cur.pm * tstep; const char* cB = (const char*)g.Bt + (size_t)cur.pn * tstep;
    S.a_ready(cur);
    { Unit pu; for (int i = 0; i < 8 && S.next(i, pu); ++i) E.prep(tabs + (i << 8), pu); }
    if constexpr (SP2) {
        PG8_STAGE(PG8_SB(0, 0), cB, voffB); PG8_STAGE(PG8_SB(0, 1), cB + hstep, voffB); PG8_STAGE(PG8_SA(0, 0), cA, voffA); PG8_STAGE(PG8_SA(0, 1), cA + hstep, voffA);
        if (wr == 1) PG8_BAR;
        PG8_WAIT_V(2); PG8_BAR;
        PG8_STAGE(PG8_SB(1, 0), cB + kstep, voffB); PG8_STAGE(PG8_SA(1, 0), cA + kstep, voffA); PG8_STAGE(PG8_SB(1, 1), cB + hstep + kstep, voffB);
        PG8_WAIT_V(6); PG8_BAR;
    } else {
        PG8_STAGE(PG8_SB(0, 0), cB, voffB); PG8_STAGE(PG8_SA(0, 0), cA, voffA); PG8_STAGE(PG8_SB(0, 1), cB + hstep, voffB); PG8_STAGE(PG8_SA(0, 1), cA + hstep, voffA);
        if (wr == 1) PG8_BAR;
        PG8_WAIT_V(4); PG8_BAR;
        PG8_STAGE(PG8_SB(1, 0), cB + kstep, voffB); PG8_STAGE(PG8_SA(1, 0), cA + kstep, voffA); PG8_STAGE(PG8_SB(1, 1), cB + hstep + kstep, voffB);
        PG8_WAIT_V(6); PG8_BAR;
    }
    for (;;) {
        const bool has_next = S.next(ui + 1, nxt);
        const char* nA = has_next ? (const char*)g.A + (size_t)nxt.pm * tstep : cA; const char* nB = has_next ? (const char*)g.Bt + (size_t)nxt.pn * tstep : cB;
        for (int t = 0; t < nt; t += 2) {
            const bool last = (t == nt - 2);
            const char* a1 = cA + (size_t)(t + 1) * kstep;
            const char* a2 = last ? nA : cA + (size_t)(t + 2) * kstep; const char* b2 = last ? nB : cB + (size_t)(t + 2) * kstep;
            const char* a3 = a2 + kstep; const char* b3 = b2 + kstep;
            if (last && has_next) S.a_ready(nxt);
            if constexpr (SP2) {
            PG8_LDB(B0, 0, 0); PG8_LDB(B1, 0, 1); PG8_SCHED; PG8_LDA(At, 0, 0); PG8_STAGE(PG8_SA(1, 1), a1 + hstep, voffA);
            PG8_WAIT_V(8); PG8_WAIT_L(0); PG8_BAR; PG8_MMA(0, 0, At, B0); PG8_MMA(0, 1, At, B1); PG8_BAR; PG8_SCHED;
            PG8_LDA(At, 0, 1); PG8_STAGE(PG8_SB(0, 0), b2, voffB); PG8_STAGE(PG8_SB(0, 1), b2 + hstep, voffB); PG8_STAGE(PG8_SA(0, 0), a2, voffA);
            PG8_WAIT_V(8); PG8_WAIT_L(0); PG8_BAR; PG8_MMA(1, 0, At, B0); PG8_MMA(1, 1, At, B1); PG8_BAR; PG8_SCHED;
            PG8_LDB(B0, 1, 0); PG8_LDB(B1, 1, 1); PG8_SCHED; PG8_LDA(At, 1, 0); PG8_STAGE(PG8_SA(0, 1), a2 + hstep, voffA);
            PG8_WAIT_V(8); PG8_WAIT_L(0); PG8_BAR; PG8_MMA(0, 0, At, B0); PG8_MMA(0, 1, At, B1); PG8_BAR; PG8_SCHED;
            PG8_LDA(At, 1, 1); PG8_STAGE(PG8_SB(1, 0), b3, voffB); PG8_STAGE(PG8_SB(1, 1), b3 + hstep, voffB); PG8_STAGE(PG8_SA(1, 0), a3, voffA);
            PG8_WAIT_V(8); PG8_WAIT_L(0); PG8_BAR; PG8_MMA(1, 0, At, B0); PG8_MMA(1, 1, At, B1); PG8_BAR; PG8_SCHED;
            } else {
            PG8_LDB(B0, 0, 0); PG8_SCHED; PG8_LDA(At, 0, 0); PG8_STAGE(PG8_SA(1, 1), a1 + hstep, voffA);
            PG8_WAIT_L(8); PG8_BAR; PG8_WAIT_L(0); PG8_MMA(0, 0, At, B0); PG8_BAR; PG8_SCHED;
            PG8_LDB(B1, 0, 1); PG8_STAGE(PG8_SB(0, 0), b2, voffB);
            PG8_BAR; PG8_WAIT_L(0); PG8_MMA(0, 1, At, B1); PG8_BAR;
            PG8_LDA(At, 0, 1); PG8_STAGE(PG8_SA(0, 0), a2, voffA);
            PG8_BAR; PG8_WAIT_L(0); PG8_MMA(1, 0, At, B0); PG8_BAR; PG8_SCHED;
            PG8_STAGE(PG8_SB(0, 1), b2 + hstep, voffB);
            PG8_WAIT_V(6); PG8_BAR; PG8_MMA(1, 1, At, B1); PG8_BAR;
            PG8_LDB(B0, 1, 0); PG8_SCHED; PG8_LDA(At, 1, 0); PG8_STAGE(PG8_SA(0, 1), a2 + hstep, voffA);
            PG8_WAIT_L(8); PG8_BAR; PG8_WAIT_L(0); PG8_MMA(0, 0, At, B0); PG8_BAR; PG8_SCHED;
            PG8_LDB(B1, 1, 1); PG8_STAGE(PG8_SB(1, 0), b3, voffB);
            PG8_BAR; PG8_WAIT_L(0); PG8_MMA(0, 1, At, B1); PG8_BAR;
            PG8_LDA(At, 1, 1); PG8_STAGE(PG8_SA(1, 0), a3, voffA);
            PG8_BAR; PG8_WAIT_L(0); PG8_MMA(1, 0, At, B0); PG8_BAR; PG8_SCHED;
            PG8_STAGE(PG8_SB(1, 1), b3 + hstep, voffB);
            PG8_WAIT_V(6); PG8_BAR; PG8_MMA(1, 1, At, B1); PG8_BAR;
            }
        }
        if constexpr (ALIGN_EPI) { if (wr == 0) PG8_BAR; }
        if constexpr (!Epi::AFTER_DRAIN) { E(acc, cur, wr, wc, fr, fq, tabs + (ui << 8)); S.done(cur); }
        if (!has_next) break;
#pragma unroll
        for (int a = 0; a < 2; ++a)
#pragma unroll
            for (int b = 0; b < 2; ++b)
#pragma unroll
                for (int m = 0; m < 4; ++m)
#pragma unroll
                    for (int n = 0; n < 2; ++n) acc[a][b][m][n] = (f32x4){0.f, 0.f, 0.f, 0.f};
        cur = nxt; cA = nA; cB = nB; ++ui;
        if constexpr (ALIGN_EPI) { if (wr == 1) PG8_BAR; }
    }
    PG8_WAIT_V(0);
    if constexpr (!ALIGN_EPI) { if (wr == 0) PG8_BAR; }
    PG8_BAR;
    if constexpr (Epi::AFTER_DRAIN) { E.fused(acc, cur, wr, wc, fr, fq, lds, wid, lane); S.done(cur); }
#undef PG8_SA
#undef PG8_SB
#undef PG8_STAGE
#undef PG8_LDA
#undef PG8_LDB
#undef PG8_MMA
#undef PG8_WAIT_V
#undef PG8_WAIT_L
#undef PG8_BAR
#undef PG8_SCHED
}
}
#define XB_TMO      128
#define XB_XCNT(j)  (256  + 64 * (j))
#define XB_XSUB(j)  (1280 + 64 * (j))
#define XB_XGEN(j)  (2304 + 64 * (j))
#define XB_TOP      3328
#define XB_TOPGEN   3392
#define XCD_BAR_WORDS 3456
#define XB_SPIN_CAP (1u << 18)

__device__ __forceinline__ unsigned xb_ld(unsigned* p)              { return __hip_atomic_load(p, __ATOMIC_RELAXED, __HIP_MEMORY_SCOPE_AGENT); }
__device__ __forceinline__ unsigned xb_add(unsigned* p, unsigned v) { return __hip_atomic_fetch_add(p, v, __ATOMIC_RELAXED, __HIP_MEMORY_SCOPE_AGENT); }
__device__ __forceinline__ unsigned xb_xcc_id() { return (unsigned)__builtin_amdgcn_s_getreg((3 << 11) | 20) & 0xFu; }
#define XB_SPIN(cond, bar) do { unsigned _sp = 0; while (cond) { __builtin_amdgcn_s_sleep(1); \
    if ((++_sp & 255u) == 0u) { if (xb_ld(&(bar)[XB_TMO])) break; if (_sp > XB_SPIN_CAP) { atomicAdd(&(bar)[XB_TMO], 1u); break; } } } } while (0)

struct XcdBarrier {
    unsigned* bar; unsigned x;
    volatile LAS unsigned* st;
};

__device__ __forceinline__ XcdBarrier xcd_barrier_post(unsigned* bar, volatile LAS unsigned* st) {
    XcdBarrier b; b.bar = bar; b.x = xb_xcc_id(); b.st = st;
    if (threadIdx.x == 0) (void)xb_add(&bar[XB_XCNT(b.x)], 1u);
    return b;
}
__device__ __forceinline__ void xcd_barrier_complete(unsigned* bar, unsigned x, unsigned& nloc, unsigned& nx) {
    const unsigned G = gridDim.x * gridDim.y * gridDim.z;
    unsigned sum, cnt, mine, sp = 0u;
    for (;;) {
        sum = 0u; cnt = 0u; mine = 0u;
#pragma unroll
        for (unsigned j = 0; j < 16; ++j) { const unsigned c = xb_ld(&bar[XB_XCNT(j)]); sum += c; cnt += (c > 0u) ? 1u : 0u; mine = (j == x) ? c : mine; }
        if (sum == G) break;
        __builtin_amdgcn_s_sleep(1);
        if ((++sp & 255u) == 0u) { if (xb_ld(&bar[XB_TMO])) break; if (sp > XB_SPIN_CAP) { atomicAdd(&bar[XB_TMO], 1u); break; } }
    }
    nloc = mine > 0u ? mine : 1u; nx = cnt > 0u ? cnt : 1u;
}

__device__ __forceinline__ void xcd_barrier(const XcdBarrier& b) {
    asm volatile("s_waitcnt vmcnt(0)" ::: "memory");
    __syncthreads();
    if (threadIdx.x == 0) {
        unsigned* bar = b.bar;
        __builtin_amdgcn_s_waitcnt(0);
        unsigned nloc = b.st[0], nx = b.st[1];
        if (nloc == 0u) { xcd_barrier_complete(bar, b.x, nloc, nx); b.st[0] = nloc; b.st[1] = nx; }
        const unsigned old = xb_add(&bar[XB_XSUB(b.x)], 1u);
        const unsigned gen = old / nloc;
        if (old + 1u == (gen + 1u) * nloc) {
            __builtin_amdgcn_fence(__ATOMIC_RELEASE, "agent");
            asm volatile("s_waitcnt vmcnt(0)" ::: "memory");
            const unsigned og = xb_add(&bar[XB_TOP], 1u);
            const unsigned tg = og / nx;
            if (og + 1u == (tg + 1u) * nx) xb_add(&bar[XB_TOPGEN], 1u);
            else XB_SPIN(xb_ld(&bar[XB_TOPGEN]) == tg, bar);
            __builtin_amdgcn_fence(__ATOMIC_ACQUIRE, "agent");
            xb_add(&bar[XB_XGEN(b.x)], 1u);
            asm volatile("s_waitcnt vmcnt(0)" ::: "memory");
        } else {
            XB_SPIN(xb_ld(&bar[XB_XGEN(b.x)]) == gen, bar);
            __builtin_amdgcn_fence(__ATOMIC_ACQUIRE, "agent");
            asm volatile("s_waitcnt vmcnt(0)" ::: "memory");
        }
    }
    __syncthreads();
}

namespace gla {
constexpr int RP = 272;
constexpr int L_QD = 0, L_KI = 17408, L_KE = 34816, L_VV = 51200, L_OT = 67584, OT_PITCH = 528, L_XCH = 67584, L_QTOT = 101376, L_DK = 105472, L_SS = 105984, L_END = 107008;
static_assert(L_QD + 64 * RP <= L_KI && L_KI + 64 * RP <= L_KE && L_OT + 64 * OT_PITCH <= L_QTOT && L_END <= RING_BYTES, "gla LDS map");
__device__ __forceinline__ s16x4 vtr(const LAS unsigned char* p) { typedef short v4i16_t __attribute__((ext_vector_type(4))); return __builtin_bit_cast(s16x4, __builtin_amdgcn_ds_read_tr16_b64_v4i16((LAS v4i16_t*)p)); }
#define GLA_MFMA(a, b, c) __builtin_amdgcn_mfma_f32_32x32x16_bf16(a, b, c, 0, 0, 0)
__device__ __forceinline__ void unit(LAS unsigned char* lds, const bf16* Q, bf16* Oout, int omask, const bf16* KK, const bf16* LF, const bf16* I, const bf16* G, const float* gnorm,
                                     int row0, int nchunks, int h, const float* s0, float* sfin) {
    const int tid = threadIdx.x, lane = tid & 63, r = lane & 31, hi = lane >> 5; const int w = __builtin_amdgcn_readfirstlane(tid >> 6);
    const int vt = w & 3, hf = w >> 2;
    f32x16 S[4];
#pragma unroll
    for (int kt = 0; kt < 4; ++kt)
#pragma unroll
        for (int g = 0; g < 16; ++g) S[kt][g] = s0 ? s0[(size_t)(32 * kt + crow(g, hi)) * 128 + 32 * vt + r] : 0.f;
    float gn8[8];
#pragma unroll
    for (int j = 0; j < 8; ++j) gn8[j] = gnorm[8 * (tid & 15) + j];
    LAS float* qtot = (LAS float*)(lds + L_QTOT); LAS float* dk = (LAS float*)(lds + L_DK); LAS float* ssl = (LAS float*)(lds + L_SS);
    unsigned lfr[8], qvr[8], kvr[8]; v4u vxr[2];
#define GLA_LOAD(nn) do { const int mm_ = row0 + 64 * (nn); const size_t go_ = (size_t)(mm_ + 8 * w) * DM + h * 128 + 2 * lane; \
        _Pragma("unroll") for (int i = 0; i < 8; ++i) { lfr[i] = *(const unsigned*)(LF + go_ + (size_t)i * DM); qvr[i] = *(const unsigned*)(Q + go_ + (size_t)i * DM); kvr[i] = *(const unsigned*)(KK + go_ + (size_t)i * DM); } \
        _Pragma("unroll") for (int j = 0; j < 2; ++j) { const int p_ = tid + 512 * j; vxr[j] = *(const v4u*)(I + (size_t)(mm_ + (p_ >> 4)) * DM + h * 128 + 8 * (p_ & 15)); } } while (0)
    GLA_LOAD(0);
    for (int n = 0; n < nchunks; ++n) {
        const int m0 = row0 + 64 * n;
        int tid_ = threadIdx.x; asm volatile("" : "+v"(tid_));
        const int tid = tid_, lane = tid & 63, r = lane & 31, hi = lane >> 5;
        {
            float c0[8], c1[8]; float run0 = 0.f, run1 = 0.f;
#pragma unroll
            for (int i = 0; i < 8; ++i) { run0 += bf_lo(lfr[i]); run1 += bf_hi(lfr[i]); c0[i] = run0; c1[i] = run1; }
            typedef float f32x2_t __attribute__((ext_vector_type(2)));
            LAS f32x2_t* qtot2 = (LAS f32x2_t*)qtot;
            qtot2[w * 64 + lane] = (f32x2_t){run0, run1};
#pragma unroll
            for (int j = 0; j < 2; ++j) { const int p = tid + 512 * j, s = p >> 4, v8 = p & 15;
                *(LAS v4u*)(lds + L_VV + (v8 >> 2) * 4096 + s * 64 + (v8 & 3) * 16) = vxr[j]; }
            __syncthreads();
            float pre0 = 0.f, pre1 = 0.f, bt0 = 0.f, bt1 = 0.f;
#pragma unroll
            for (int ww = 0; ww < 8; ++ww) { const f32x2_t t_ = qtot2[ww * 64 + lane]; bt0 += t_[0]; bt1 += t_[1]; if (ww < w) { pre0 += t_[0]; pre1 += t_[1]; } }
            const float eb0 = __expf(bt0), eb1 = __expf(bt1);
#pragma unroll
            for (int i = 0; i < 8; ++i) { const int t = 8 * w + i; const float e0 = __expf(pre0 + c0[i]), e1 = __expf(pre1 + c1[i]);
                const float ki0 = bf_lo(kvr[i]) * __builtin_amdgcn_rcpf(e0), ki1 = bf_hi(kvr[i]) * __builtin_amdgcn_rcpf(e1);
                const int ro = t * RP + lane * 4;
                *(LAS unsigned*)(lds + L_QD + ro) = pk_bf16(bf_lo(qvr[i]) * e0, bf_hi(qvr[i]) * e1);
                *(LAS unsigned*)(lds + L_KI + ro) = pk_bf16(ki0, ki1);
                *(LAS unsigned*)(lds + L_KE + (lane >> 4) * 4096 + t * 64 + (lane & 15) * 4) = pk_bf16(ki0 * eb0, ki1 * eb1); }
            if (w == 0) { dk[2 * lane] = eb0; dk[2 * lane + 1] = eb1; }
            if (n + 1 < nchunks) GLA_LOAD(n + 1);
            __syncthreads();
        }
        v4u ggr[2];
#pragma unroll
        for (int j = 0; j < 2; ++j) { const int p = tid + 512 * j; ggr[j] = *(const v4u*)(G + (size_t)(m0 + (p >> 4)) * DM + h * 128 + 8 * (p & 15)); }
        f32x16 o;
#pragma unroll
        for (int g = 0; g < 16; ++g) o[g] = 0.f;
        {
            const int row = 32 * hf + r;
#pragma unroll
            for (int kt = 0; kt < 4; ++kt)
#pragma unroll
                for (int ksl = 0; ksl < 2; ++ksl) {
                    const int chunk = 4 * kt + 2 * ksl;
                    const v2u b0 = *(const LAS v2u*)(lds + L_QD + row * RP + chunk * 16 + 8 * hi);
                    const v2u b1 = *(const LAS v2u*)(lds + L_QD + row * RP + (chunk + 1) * 16 + 8 * hi);
                    const v4u bq = (v4u){b0.x, b0.y, b1.x, b1.y};
                    const v4u aq = (v4u){pk_bf16(S[kt][8 * ksl + 0], S[kt][8 * ksl + 1]), pk_bf16(S[kt][8 * ksl + 2], S[kt][8 * ksl + 3]),
                                         pk_bf16(S[kt][8 * ksl + 4], S[kt][8 * ksl + 5]), pk_bf16(S[kt][8 * ksl + 6], S[kt][8 * ksl + 7])};
                    o = GLA_MFMA(__builtin_bit_cast(bf16x8, aq), __builtin_bit_cast(bf16x8, bq), o);
                }
        }
        bf16x8 vf[4];
        {
            const LAS unsigned char* vb = lds + L_VV + vt * 4096 + ((lane >> 4) & 1) * 32 + (lane & 3) * 8 + (4 * hi + ((lane & 15) >> 2)) * 64;
#pragma unroll
            for (int ks = 0; ks < 4; ++ks) { const s16x4 lo = vtr(vb + ks * 1024), hh = vtr(vb + ks * 1024 + 512); vf[ks] = (bf16x8){lo[0], lo[1], lo[2], lo[3], hh[0], hh[1], hh[2], hh[3]}; }
        }
        for (int st = 0; st <= hf; ++st) {
            f32x16 X;
#pragma unroll
            for (int g = 0; g < 16; ++g) X[g] = 0.f;
            const int rs_ = 32 * st + r, rt_ = 32 * hf + r;
#pragma unroll
            for (int k8 = 0; k8 < 8; ++k8) {
                const bf16x8 a = *(const LAS bf16x8*)(lds + L_KI + rs_ * RP + (2 * k8 + hi) * 16);
                const bf16x8 b = *(const LAS bf16x8*)(lds + L_QD + rt_ * RP + (2 * k8 + hi) * 16);
                X = GLA_MFMA(a, b, X);
            }
            if (st == hf) {
#pragma unroll
                for (int g = 0; g < 16; ++g) if (crow(g, hi) > r) X[g] = 0.f;
            }
            const v4u x0 = (v4u){pk_bf16(X[0], X[1]), pk_bf16(X[2], X[3]), pk_bf16(X[4], X[5]), pk_bf16(X[6], X[7])};
            const v4u x1 = (v4u){pk_bf16(X[8], X[9]), pk_bf16(X[10], X[11]), pk_bf16(X[12], X[13]), pk_bf16(X[14], X[15])};
            if (st == 0) { o = GLA_MFMA(vf[0], __builtin_bit_cast(bf16x8, x0), o); o = GLA_MFMA(vf[1], __builtin_bit_cast(bf16x8, x1), o); }
            else         { o = GLA_MFMA(vf[2], __builtin_bit_cast(bf16x8, x0), o); o = GLA_MFMA(vf[3], __builtin_bit_cast(bf16x8, x1), o); }
        }
#pragma unroll
        for (int kt = 0; kt < 4; ++kt) {
#pragma unroll
            for (int j = 0; j < 4; ++j) { const f32x4 d4 = *(const LAS f32x4*)(dk + 32 * kt + 8 * j + 4 * hi);
                S[kt][4 * j + 0] *= d4[0]; S[kt][4 * j + 1] *= d4[1]; S[kt][4 * j + 2] *= d4[2]; S[kt][4 * j + 3] *= d4[3]; }
            const LAS unsigned char* kb = lds + L_KE + kt * 4096 + ((lane >> 4) & 1) * 32 + (lane & 3) * 8 + (4 * hi + ((lane & 15) >> 2)) * 64;
#pragma unroll
            for (int ks = 0; ks < 4; ++ks) { const s16x4 lo = vtr(kb + ks * 1024), hh = vtr(kb + ks * 1024 + 512);
                const bf16x8 a = (bf16x8){lo[0], lo[1], lo[2], lo[3], hh[0], hh[1], hh[2], hh[3]};
                S[kt] = GLA_MFMA(a, vf[ks], S[kt]); }
        }
        {
            float ssq = 0.f;
#pragma unroll
            for (int g = 0; g < 16; ++g) ssq += o[g] * o[g];
            ssq += __shfl_xor(ssq, 32);
            const int t = 32 * hf + r;
            if (hi == 0) ssl[vt * 64 + t] = ssq;
#pragma unroll
            for (int j = 0; j < 4; ++j) *(LAS f32x4*)(lds + L_OT + t * OT_PITCH + (32 * vt + 8 * j + 4 * hi) * 4) = (f32x4){o[4 * j], o[4 * j + 1], o[4 * j + 2], o[4 * j + 3]};
        }
        __syncthreads();
#pragma unroll
        for (int j = 0; j < 2; ++j) { const int p = tid + 512 * j, t = p >> 4, c8 = p & 15;
            const float rn = rsqrtf(((ssl[t] + ssl[64 + t]) + (ssl[128 + t] + ssl[192 + t])) * (1.0f / 128.0f) + EPS);
            const f32x4 a = *(const LAS f32x4*)(lds + L_OT + t * OT_PITCH + c8 * 32), b = *(const LAS f32x4*)(lds + L_OT + t * OT_PITCH + c8 * 32 + 16);
            const v4u gg = ggr[j];
            v4u ov; ov.x = pk_bf16(a[0] * rn * gn8[0] * bf_lo(gg.x), a[1] * rn * gn8[1] * bf_hi(gg.x)); ov.y = pk_bf16(a[2] * rn * gn8[2] * bf_lo(gg.y), a[3] * rn * gn8[3] * bf_hi(gg.y));
            ov.z = pk_bf16(b[0] * rn * gn8[4] * bf_lo(gg.z), b[1] * rn * gn8[5] * bf_hi(gg.z)); ov.w = pk_bf16(b[2] * rn * gn8[6] * bf_lo(gg.w), b[3] * rn * gn8[7] * bf_hi(gg.w));
            *(v4u*)(Oout + (size_t)((m0 + t) & omask) * DM + h * 128 + 8 * c8) = ov; }
    }
    if (hf == 0) {
#pragma unroll
        for (int kt = 0; kt < 4; ++kt)
#pragma unroll
            for (int g = 0; g < 16; ++g) sfin[(size_t)(32 * kt + crow(g, hi)) * 128 + 32 * vt + r] = S[kt][g]; }
    __syncthreads();
}
#undef GLA_MFMA
#undef GLA_LOAD
}

namespace att2 {
using bf16x8=__attribute__((ext_vector_type(8)))short;
using s16x4=__attribute__((ext_vector_type(4)))short;
using f32x16=__attribute__((ext_vector_type(16)))float;
using u32x4=__attribute__((ext_vector_type(4)))unsigned;
constexpr int NHEAD=16,SEQ=2048,D=64,DM=NHEAD*D;
constexpr int NW=8,QBLK=32,QB=QBLK*NW,KVBLK=64,NQB=SEQ/QB;
constexpr int ATTN_PITCH=DM, ATTN_UNIT_ROWS=QB;
__device__ __forceinline__ int crow(int r,int hi){return (r&3)+8*(r>>2)+4*hi;}
#define SBAR() __builtin_amdgcn_sched_barrier(0)
__device__ __forceinline__ void cmask(f32x16&p0,f32x16&p1,int jb,int qrel,int hi){
  const float NEG=-__builtin_inff(); int kb=64*jb+4*hi;
  #pragma unroll
  for(int r=0;r<16;++r){int kv=kb+(r&3)+8*(r>>2); if(kv>qrel)p0[r]=NEG; if(kv+32>qrel)p1[r]=NEG;}
}

constexpr int NSLOT=3, SLOTB=8192;
constexpr int LDS_K=0, LDS_V=NSLOT*SLOTB, LDS_WS=2*NSLOT*SLOTB, LDS_OST=LDS_WS+NW*64*4, LDS_FK=LDS_OST+NW*4096, LDS_CJ=LDS_FK+8192, LDS_BYTES=LDS_CJ+256;
constexpr float C2=0.125f*1.4426950408889634f;
__device__ __forceinline__ void glds16(const void*gsrc,unsigned lds_dst){unsigned keep;
  asm volatile("s_mov_b32 %0, m0\n\ts_mov_b32 m0, %2\n\ts_nop 0\n\tglobal_load_lds_dwordx4 %1, off\n\ts_mov_b32 m0, %0":"=&s"(keep):"v"(gsrc),"s"(lds_dst):"memory");}
__device__ __forceinline__ float max3f(float a,float b,float c){float r;asm("v_max3_f32 %0, %1, %2, %3":"=v"(r):"v"(a),"v"(b),"v"(c));return r;}
__device__ __forceinline__ float max2f(float a,float b){float r;asm("v_max_f32_e32 %0, %1, %2":"=v"(r):"v"(a),"v"(b));return r;}
__device__ __forceinline__ float fadd_s(float a,float b){float r;asm("v_add_f32_e32 %0, %1, %2":"=v"(r):"v"(a),"v"(b));return r;}
__device__ __forceinline__ float fsub_s(float a,float b){float r;asm("v_sub_f32_e32 %0, %1, %2":"=v"(r):"v"(a),"v"(b));return r;}
typedef float f32x2_t __attribute__((ext_vector_type(2))); typedef __bf16 bf16x2_t __attribute__((ext_vector_type(2)));
__device__ __forceinline__ unsigned cvtpk_s(float lo,float hi){f32x2_t v={lo,hi};bf16x2_t b=__builtin_convertvector(v,bf16x2_t);return __builtin_bit_cast(unsigned,b);}
#define WAIT_BAR(N) asm volatile("s_waitcnt vmcnt(" #N ") lgkmcnt(0)\n\ts_barrier":::"memory")

__device__ __forceinline__ void qkt(f32x16&p0,f32x16&p1,const char*Kslot,const bf16x8*qr,int r32,int hi){
  const char*kb=Kslot+hi*1024+r32*16;
  #pragma unroll
  for(int d0=0;d0<4;++d0){
    const bf16x8 b0=*reinterpret_cast<const bf16x8*>(kb+d0*2048);
    const bf16x8 b1=*reinterpret_cast<const bf16x8*>(kb+d0*2048+512);
    p0=__builtin_amdgcn_mfma_f32_32x32x16_bf16(b0,qr[d0],p0,0,0,0);p1=__builtin_amdgcn_mfma_f32_32x32x16_bf16(b1,qr[d0],p1,0,0,0);}
}
typedef __attribute__((address_space(3))) const char* lds_cptr;
typedef short v4i16_t __attribute__((ext_vector_type(4)));
__device__ __forceinline__ void kload8(bf16x8*kf,lds_cptr kp){
  kf[0]=*(const __attribute__((address_space(3))) bf16x8*)(kp);      kf[1]=*(const __attribute__((address_space(3))) bf16x8*)(kp+512);
  kf[2]=*(const __attribute__((address_space(3))) bf16x8*)(kp+2048); kf[3]=*(const __attribute__((address_space(3))) bf16x8*)(kp+2560);
  kf[4]=*(const __attribute__((address_space(3))) bf16x8*)(kp+4096); kf[5]=*(const __attribute__((address_space(3))) bf16x8*)(kp+4608);
  kf[6]=*(const __attribute__((address_space(3))) bf16x8*)(kp+6144); kf[7]=*(const __attribute__((address_space(3))) bf16x8*)(kp+6656);
}
__device__ __forceinline__ void kload2(bf16x8*kf,lds_cptr kp,int j){ kf[2*j]=*(const __attribute__((address_space(3))) bf16x8*)(kp+j*2048); kf[2*j+1]=*(const __attribute__((address_space(3))) bf16x8*)(kp+j*2048+512); }
__device__ __forceinline__ s16x4 vtr(lds_cptr p){ return __builtin_bit_cast(s16x4,__builtin_amdgcn_ds_read_tr16_b64_v4i16((__attribute__((address_space(3))) v4i16_t*)p)); }
__device__ __forceinline__ float rowmax(const f32x16&p0,const f32x16&p1){
  float a=max3f(p0[0],p0[1],p1[0]),b=max3f(p0[2],p0[3],p1[1]);a=max3f(a,p1[2],p1[3]);
  #pragma unroll
  for(int r=4;r<16;r+=4){a=max3f(a,p0[r],p0[r+1]);b=max3f(b,p0[r+2],p0[r+3]);a=max3f(a,p1[r],p1[r+1]);b=max3f(b,p1[r+2],p1[r+3]);}
  const float m=max2f(a,b);
  auto rr=__builtin_amdgcn_permlane32_swap(__float_as_uint(m),__float_as_uint(m),false,false);
  return max2f(__uint_as_float(rr[0]),__uint_as_float(rr[1]));
}
__device__ __forceinline__ void pv(f32x16*o,int vb,bf16x8 pa0,bf16x8 pa1,bf16x8 pa2,bf16x8 pa3){
  #pragma unroll
  for(int d0=0;d0<2;++d0){s16x4 lo[4],hi[4];
    #pragma unroll
    for(int ks=0;ks<4;++ks){
      asm volatile("ds_read_b64_tr_b16 %0,%1 offset:%c2":"=&v"(lo[ks]):"v"(vb),"i"(d0*4096+ks*1024):"memory");
      asm volatile("ds_read_b64_tr_b16 %0,%1 offset:%c2":"=&v"(hi[ks]):"v"(vb),"i"(d0*4096+ks*1024+512):"memory");}
    asm volatile("s_waitcnt lgkmcnt(0)":::"memory");SBAR();
    #define PK(k) (bf16x8){lo[k][0],lo[k][1],lo[k][2],lo[k][3],hi[k][0],hi[k][1],hi[k][2],hi[k][3]}
    o[d0]=__builtin_amdgcn_mfma_f32_32x32x16_bf16(pa0,PK(0),o[d0],0,0,0);
    o[d0]=__builtin_amdgcn_mfma_f32_32x32x16_bf16(pa1,PK(1),o[d0],0,0,0);
    o[d0]=__builtin_amdgcn_mfma_f32_32x32x16_bf16(pa2,PK(2),o[d0],0,0,0);
    o[d0]=__builtin_amdgcn_mfma_f32_32x32x16_bf16(pa3,PK(3),o[d0],0,0,0);
    #undef PK
  }
}

#ifndef ATTN_STORE16
#define ATTN_STORE16(p,v) (*(u32x4*)(p)=(v))
#endif
template<int THRL> __device__ __forceinline__ void attn_unit(int b,int h,int qb,const bf16*Q,const bf16*__restrict__ K,const bf16*__restrict__ V,const bf16*__restrict__ G,bf16*O,const unsigned*__restrict__ FKP,const float*__restrict__ CEND,char*shm){
  int tid_=threadIdx.x; asm volatile("":"+v"(tid_));
  const int tid=tid_,lane=tid&63,r32=lane&31,hi=lane>>5; const int wid=__builtin_amdgcn_readfirstlane(tid>>6);
  const long rowbase=(long)b*SEQ; const int q0=qb*QB;
  const bf16*Qw=Q+(rowbase+q0+wid*QBLK)*DM+h*D;
  const bf16*Kh=K+rowbase*DM+h*D,*Vh=V+rowbase*DM+h*D;
  const unsigned lds0=(unsigned)(uintptr_t)shm;
  float*wsf=(float*)(shm+LDS_WS)+wid*64;
  const float*wsh=wsf+4*hi;
  const bf16*ksrc=Kh+(long)lane*DM+wid*8;
  const bf16*vsrc=Vh+(long)(16*(wid&3)+(lane>>2))*DM+(wid>>2)*32+(lane&3)*8;
  const unsigned kdst=lds0+LDS_K+wid*1024, vdst=lds0+LDS_V+wid*1024;
  #define DMA_K(t,slot) glds16(ksrc+(long)(NT-1-(t))*KVBLK*DM,(unsigned)__builtin_amdgcn_readfirstlane(kdst+(slot)))
  #define DMA_V(t,slot) glds16(vsrc+(long)(NT-1-(t))*KVBLK*DM,(unsigned)__builtin_amdgcn_readfirstlane(vdst+(slot)))
  const int vb0=(int)(lds0+LDS_V)+((lane>>4)&1)*32+(lane&3)*8+(4*hi+((lane&15)>>2))*64;
  const char*Kbase=shm+LDS_K; bf16x8 kf[8];
  const lds_cptr shm3=(lds_cptr)shm; const lds_cptr kp0=shm3+LDS_K+hi*1024+r32*16; const lds_cptr vp0=shm3+LDS_V+((lane>>4)&1)*32+(lane&3)*8+(4*hi+((lane&15)>>2))*64;
  const int NT=(q0+QB)/KVBLK;
  DMA_K(0,0);DMA_V(0,0);DMA_K(1,SLOTB);
  unsigned*fkl=(unsigned*)(shm+LDS_FK); float*cjl=(float*)(shm+LDS_CJ);
  { const float cref=CEND[NT-1]; _Pragma("unroll") for(int k_=0;k_<4;++k_){const int i=tid+k_*NW*64; if(i<NT*KVBLK)fkl[i]=FKP[i];} if(tid<NT)cjl[tid]=cref-CEND[tid]; }
  bf16x8 qr[4];
  #pragma unroll
  for(int d0=0;d0<4;++d0)qr[d0]=*reinterpret_cast<const bf16x8*>(&Qw[(long)r32*DM+d0*16+hi*8]);
  float mhat=0.f,l_reg=0.f;f32x16 o[2];o[0]=f32x16{};o[1]=f32x16{};
  const unsigned ONES=0x3f803f80u;
  unsigned fk0c=0u,fk1c=0u; float cjc=0.f;
  #define BIAS_LD(t) do{ const int tl_=NT-1-(t); fk0c=fkl[tl_*KVBLK+r32]; fk1c=fkl[tl_*KVBLK+32+r32]; cjc=cjl[tl_]; }while(0)
  #define BIAS_OPS(t) const unsigned fk0_=fk0c,fk1_=fk1c; const float cj_=cjc; \
    const float x_=cj_-mhat; const unsigned xh_=cvtpk_s(x_,0.f)&0xffffu; const float xhf_=__uint_as_float(xh_<<16); const float xl_=x_-xhf_; const unsigned xp_=xh_|(cvtpk_s(xl_,0.f)<<16); \
    mhat=cj_-(xhf_+__uint_as_float(xp_&0xffff0000u)); \
    const u32x4 kx0_={fk0_,ONES,0u,0u},kx1_={fk1_,ONES,0u,0u},qx_={hi?0u:ONES,hi?0u:xp_,0u,0u}; const f32x16 z16_=f32x16{};
  #define CMASK(P0,P1,t) do{int jb_=3-(t); if(jb_>=0)cmask(P0,P1,jb_,wid*QBLK+r32,hi);}while(0)
  bool resc=false;
  #define START(P0,P1) do{ const float rm=__builtin_fmaxf(rowmax(P0,P1),-1.0e4f); resc=false; \
    { const float dl=rm; mhat=fadd_s(mhat,dl); \
      _Pragma("unroll") for(int r=0;r<16;++r){P0[r]=fsub_s(P0[r],dl);P1[r]=fsub_s(P1[r],dl);} } \
    _Pragma("unroll") for(int r=0;r<16;++r)P0[r]=__builtin_amdgcn_exp2f(P0[r]); }while(0)
  #define RESC() do{ if(resc){ asm volatile("s_waitcnt lgkmcnt(0)":::"memory"); \
      _Pragma("unroll") for(int d_=0;d_<2;++d_) _Pragma("unroll") for(int r=0;r<16;++r)o[d_][r]*=wsh[(r&3)+8*(r>>2)]; } }while(0)
  f32x16 pA0,pA1,pB0,pB1;
  int sl_prev=0,sl_cur=0,sl_next=SLOTB;
  #define ROT() do{sl_prev=sl_cur;sl_cur=sl_next;sl_next=(sl_next==(NSLOT-1)*SLOTB)?0:sl_next+SLOTB;}while(0)
  DMA_K(2,2*SLOTB);
  WAIT_BAR(3);
  BIAS_LD(0);
  { BIAS_OPS(0); pA0=__builtin_amdgcn_mfma_f32_32x32x16_bf16(__builtin_bit_cast(bf16x8,kx0_),__builtin_bit_cast(bf16x8,qx_),z16_,0,0,0); pA1=__builtin_amdgcn_mfma_f32_32x32x16_bf16(__builtin_bit_cast(bf16x8,kx1_),__builtin_bit_cast(bf16x8,qx_),z16_,0,0,0); }
  BIAS_LD(1);
  qkt(pA0,pA1,Kbase,qr,r32,hi);asm volatile("s_nop 15\n\ts_nop 7":"+v"(pA0),"+v"(pA1));CMASK(pA0,pA1,0);
  START(pA0,pA1);
  _Pragma("unroll") for(int r=0;r<16;++r)pA1[r]=__builtin_amdgcn_exp2f(pA1[r]);
  WAIT_BAR(0);
  DMA_K(3,0);DMA_V(1,SLOTB);
  ROT();
  kload8(kf,kp0+sl_cur);
  WAIT_BAR(2);
  s16x4 vlo[8],vhi[8]; u32x4 pw0,pw1,pw2,pw3;
  #define PKW(P,B) cvtpk_s(P[B],P[B+1])
  #define PAF(k) __builtin_bit_cast(bf16x8,pw##k)
  #define VFR(i) (bf16x8){vlo[i][0],vlo[i][1],vlo[i][2],vlo[i][3],vhi[i][0],vhi[i][1],vhi[i][2],vhi[i][3]}
  #define PIN(x) asm volatile("":"+v"(x))
  #define MX3(a,b,c) __builtin_fmaxf(__builtin_fmaxf((a),(b)),(c))
  #define GAPA(MF,A0,A1,A2,A3,W0,W1,PW) do{ MF; sacc+=A0; sacc+=A1; sacc+=A2; sacc+=A3; PIN(sacc); W0; W1; PIN(PW); SBAR(); }while(0)
  #define EX(v) __builtin_amdgcn_exp2f(v)
  #define GAPB(MF,X,B) do{ MF; X[B]=EX(X[B]); X[B+1]=EX(X[B+1]); X[B+2]=EX(X[B+2]); X[B+3]=EX(X[B+3]); PIN(X); SBAR(); }while(0)
  #define VRD(i) do{ vlo[i]=vtr(vp_+(((i)>>2)*4096+((i)&3)*1024)); vhi[i]=vtr(vp_+(((i)>>2)*4096+((i)&3)*1024+512)); }while(0)
  #define KRD(G,j) do{ if(G){ kload2(kf,kp0+sl_next,j); SBAR(); } }while(0)
  #define STEP(C0,C1,P0,P1,t,GK,GV,GL) do{ SBAR(); \
    const lds_cptr vp_=vp0+sl_prev; \
    { BIAS_OPS(t) \
      C0=__builtin_amdgcn_mfma_f32_32x32x16_bf16(__builtin_bit_cast(bf16x8,kx0_),__builtin_bit_cast(bf16x8,qx_),z16_,0,0,0); \
      C1=__builtin_amdgcn_mfma_f32_32x32x16_bf16(__builtin_bit_cast(bf16x8,kx1_),__builtin_bit_cast(bf16x8,qx_),z16_,0,0,0); } SBAR(); \
    VRD(0); SBAR(); float sacc=(P0[0]+P0[1]); \
    GAPA(C0=__builtin_amdgcn_mfma_f32_32x32x16_bf16(kf[0],qr[0],C0,0,0,0), P0[2],P0[3],P0[4],P0[5],     pw0[0]=PKW(P0,0), pw0[1]=PKW(P0,2), pw0); \
    VRD(4); SBAR(); GAPA(C1=__builtin_amdgcn_mfma_f32_32x32x16_bf16(kf[1],qr[0],C1,0,0,0), P0[6],P0[7],P0[8],P0[9],     pw0[2]=PKW(P0,4), pw0[3]=PKW(P0,6), pw0); \
    VRD(1); SBAR(); GAPA(C0=__builtin_amdgcn_mfma_f32_32x32x16_bf16(kf[2],qr[1],C0,0,0,0),   P0[10],P0[11],P0[12],P0[13], pw1[0]=PKW(P0,8), pw1[1]=PKW(P0,10), pw1); \
    VRD(5); SBAR(); GAPA(C1=__builtin_amdgcn_mfma_f32_32x32x16_bf16(kf[3],qr[1],C1,0,0,0),   P0[14],P0[15],P1[0],P1[1],   pw1[2]=PKW(P0,12),pw1[3]=PKW(P0,14), pw1); \
    VRD(2); SBAR(); GAPA(C0=__builtin_amdgcn_mfma_f32_32x32x16_bf16(kf[4],qr[2],C0,0,0,0),   P1[2],P1[3],P1[4],P1[5],     pw2[0]=PKW(P1,0), pw2[1]=PKW(P1,2), pw2); \
    VRD(6); SBAR(); GAPA(C1=__builtin_amdgcn_mfma_f32_32x32x16_bf16(kf[5],qr[2],C1,0,0,0),   P1[6],P1[7],P1[8],P1[9],     pw2[2]=PKW(P1,4), pw2[3]=PKW(P1,6), pw2); \
    VRD(3); SBAR(); GAPA(C0=__builtin_amdgcn_mfma_f32_32x32x16_bf16(kf[6],qr[3],C0,0,0,0),   P1[10],P1[11],P1[12],P1[13], pw3[0]=PKW(P1,8), pw3[1]=PKW(P1,10), pw3); \
    VRD(7); SBAR(); GAPA(C1=__builtin_amdgcn_mfma_f32_32x32x16_bf16(kf[7],qr[3],C1,0,0,0),   P1[14],P1[15],0.f,0.f,       pw3[2]=PKW(P1,12),pw3[3]=PKW(P1,14), pw3); \
    l_reg+=sacc; \
    if(GK){DMA_K((t)+3,sl_cur);} if(GV){DMA_V((t)+1,sl_next);} \
    CMASK(C0,C1,t); \
    { float a=MX3(C0[0],C0[1],C1[0]),b=MX3(C0[2],C0[3],C1[1]); a=MX3(a,C1[2],C1[3]); \
      _Pragma("unroll") for(int r=4;r<16;r+=4){a=MX3(a,C0[r],C0[r+1]);b=MX3(b,C0[r+2],C0[r+3]);a=MX3(a,C1[r],C1[r+1]);b=MX3(b,C1[r+2],C1[r+3]);} \
      float rm=__builtin_fmaxf(a,b); { auto rr=__builtin_amdgcn_permlane32_swap(__float_as_uint(rm),__float_as_uint(rm),false,false); rm=__builtin_fmaxf(__uint_as_float(rr[0]),__uint_as_float(rr[1])); } \
      resc=false; \
      if(__builtin_expect(__any(rm>(float)THRL),0)){ const float dl=__builtin_fmaxf(rm,0.f); mhat+=dl; \
        _Pragma("unroll") for(int r=0;r<16;++r){C0[r]-=dl;C1[r]-=dl;} \
        const float f=__builtin_amdgcn_exp2f(-dl); l_reg*=f; if(hi==0)wsf[r32]=f; resc=true; } } \
    if(GV){BIAS_LD((t)+1);} \
    SBAR(); \
    GAPB(o[0]=__builtin_amdgcn_mfma_f32_32x32x16_bf16(PAF(0),VFR(0),o[0],0,0,0), C0,0); \
    GAPB(o[1]=__builtin_amdgcn_mfma_f32_32x32x16_bf16(PAF(0),VFR(4),o[1],0,0,0), C0,4); \
    KRD(GL,0); GAPB(o[0]=__builtin_amdgcn_mfma_f32_32x32x16_bf16(PAF(1),VFR(1),o[0],0,0,0), C0,8); \
    KRD(GL,1); GAPB(o[1]=__builtin_amdgcn_mfma_f32_32x32x16_bf16(PAF(1),VFR(5),o[1],0,0,0), C0,12); \
    KRD(GL,2); GAPB(o[0]=__builtin_amdgcn_mfma_f32_32x32x16_bf16(PAF(2),VFR(2),o[0],0,0,0), C1,0); \
    KRD(GL,3); GAPB(o[1]=__builtin_amdgcn_mfma_f32_32x32x16_bf16(PAF(2),VFR(6),o[1],0,0,0), C1,4); \
    GAPB(o[0]=__builtin_amdgcn_mfma_f32_32x32x16_bf16(PAF(3),VFR(3),o[0],0,0,0), C1,8); \
    GAPB(o[1]=__builtin_amdgcn_mfma_f32_32x32x16_bf16(PAF(3),VFR(7),o[1],0,0,0), C1,12); \
    }while(0)
  int t=1;
  #define ENDW(tt) do{ if((tt)+3<NT){WAIT_BAR(2);} else if((tt)+2<NT){WAIT_BAR(1);} else {WAIT_BAR(0);} }while(0)
  for(;t<5&&t+1<NT;t+=2){
    STEP(pB0,pB1,pA0,pA1,t,(t+3<NT),(t+1<NT),(t+1<NT));       ENDW(t);   RESC(); ROT();
    STEP(pA0,pA1,pB0,pB1,t+1,(t+4<NT),(t+2<NT),(t+2<NT));     ENDW(t+1); RESC(); ROT();
  }
  #undef CMASK
  #define CMASK(P0,P1,t) do{}while(0)
  for(;t+5<NT;t+=2){
    STEP(pB0,pB1,pA0,pA1,t,true,true,true);     WAIT_BAR(2); RESC(); ROT();
    STEP(pA0,pA1,pB0,pB1,t+1,true,true,true);   WAIT_BAR(2); RESC(); ROT();
  }
  for(;t+1<NT;t+=2){
    STEP(pB0,pB1,pA0,pA1,t,(t+3<NT),(t+1<NT),(t+1<NT));       ENDW(t);   RESC(); ROT();
    STEP(pA0,pA1,pB0,pB1,t+1,(t+4<NT),(t+2<NT),(t+2<NT));     ENDW(t+1); RESC(); ROT();
  }
  #undef CMASK
  #define CMASK(P0,P1,t) do{int jb_=3-(t); if(jb_>=0)cmask(P0,P1,jb_,wid*QBLK+r32,hi);}while(0)
  const bf16*Gw=G+(rowbase+q0+wid*QBLK)*DM+h*D; u32x4 ggp[4];
  #pragma unroll
  for(int i=0;i<4;++i)ggp[i]=*(const u32x4*)(Gw+(long)(i*8+(lane>>3))*DM+(lane&7)*8);
  STEP(pB0,pB1,pA0,pA1,NT-1,false,false,false); RESC();
  { float sacc=pB0[0]+pB0[1]; _Pragma("unroll") for(int r=2;r<16;++r)sacc+=pB0[r]; _Pragma("unroll") for(int r=0;r<16;++r)sacc+=pB1[r]; l_reg+=sacc;
    pw0=(u32x4){PKW(pB0,0),PKW(pB0,2),PKW(pB0,4),PKW(pB0,6)};pw1=(u32x4){PKW(pB0,8),PKW(pB0,10),PKW(pB0,12),PKW(pB0,14)};pw2=(u32x4){PKW(pB1,0),PKW(pB1,2),PKW(pB1,4),PKW(pB1,6)};pw3=(u32x4){PKW(pB1,8),PKW(pB1,10),PKW(pB1,12),PKW(pB1,14)};
    SBAR(); pv(o,vb0+sl_cur,PAF(0),PAF(1),PAF(2),PAF(3)); }
  #undef PKW
  #undef PAF
  #undef VFR
  #undef PIN
  #undef MX3
  #undef GAPA
  #undef GAPB
  #undef EX
  #undef VRD
  #undef KRD
  #undef STEP
  #undef ENDW
  {auto rr=__builtin_amdgcn_permlane32_swap(__float_as_uint(l_reg),__float_as_uint(l_reg),false,false);l_reg=__uint_as_float(rr[0])+__uint_as_float(rr[1]);}
  if(hi==0)wsf[32+r32]=l_reg;asm volatile("s_waitcnt lgkmcnt(0)":::"memory");
  float rli[16];
  #pragma unroll
  for(int r=0;r<16;++r)rli[r]=__builtin_amdgcn_rcpf(wsh[32+(r&3)+8*(r>>2)]);
  bf16*Ow=O+(rowbase+q0+wid*QBLK)*DM+h*D;
  { bf16*stg=(bf16*)(shm+LDS_OST)+wid*2048;
    #pragma unroll
    for(int r=0;r<16;++r){const int orow=crow(r,hi);
      #pragma unroll
      for(int d0=0;d0<2;++d0)stg[orow*64+d0*32+r32]=(unsigned short)(cvtpk_s(o[d0][r]*rli[r],0.f)&0xffffu);}
    asm volatile("s_waitcnt lgkmcnt(0)":::"memory");
    #pragma unroll
    for(int i=0;i<4;++i){const int row=i*8+(lane>>3),ch=lane&7; const u32x4 v=*(const u32x4*)(stg+row*64+ch*8); const u32x4 gg=ggp[i]; u32x4 ov;
      ov.x=cvtpk_s(__uint_as_float(v.x<<16)*__uint_as_float(gg.x<<16),__uint_as_float(v.x&0xffff0000u)*__uint_as_float(gg.x&0xffff0000u)); ov.y=cvtpk_s(__uint_as_float(v.y<<16)*__uint_as_float(gg.y<<16),__uint_as_float(v.y&0xffff0000u)*__uint_as_float(gg.y&0xffff0000u));
      ov.z=cvtpk_s(__uint_as_float(v.z<<16)*__uint_as_float(gg.z<<16),__uint_as_float(v.z&0xffff0000u)*__uint_as_float(gg.z&0xffff0000u)); ov.w=cvtpk_s(__uint_as_float(v.w<<16)*__uint_as_float(gg.w<<16),__uint_as_float(v.w&0xffff0000u)*__uint_as_float(gg.w&0xffff0000u));
      ATTN_STORE16(Ow+(long)row*DM+ch*8,ov);} }
  asm volatile("s_waitcnt lgkmcnt(0)\n\ts_barrier":::"memory");
  #undef DMA_K
  #undef DMA_V
  #undef CMASK
  #undef START
  #undef RESC
  #undef ROT
  #undef BIAS_OPS
  #undef BIAS_LD
}
constexpr int ATTN_LDS_BYTES=LDS_BYTES;
#undef SBAR
#undef WAIT_BAR
}

namespace att3 {
constexpr int L_SCR = RING_BYTES;
__device__ __forceinline__ s16x4 vtr(const LAS unsigned char* p) { typedef short v4i16_t __attribute__((ext_vector_type(4))); return __builtin_bit_cast(s16x4, __builtin_amdgcn_ds_read_tr16_b64_v4i16((LAS v4i16_t*)p)); }
__device__ __forceinline__ void glds16(const void* gsrc, unsigned lds_dst) { unsigned keep;
    asm volatile("s_mov_b32 %0, m0\n\ts_mov_b32 m0, %2\n\ts_nop 0\n\tglobal_load_lds_dwordx4 %1, off\n\ts_mov_b32 m0, %0" : "=&s"(keep) : "v"(gsrc), "s"(lds_dst) : "memory"); }
#define A3_MFMA(a, b, c) __builtin_amdgcn_mfma_f32_32x32x16_bf16(a, b, c, 0, 0, 0)
__device__ __forceinline__ void unit(LAS unsigned char* lds, unsigned lds0, const bf16* Qrows, const bf16* Grows, bf16* Orows, const float* Kc, const float* Vc, const bf16* Kn, const bf16* Vn, const float* F) {
    int tid_ = threadIdx.x; asm volatile("" : "+v"(tid_));
    const int tid = tid_, lane = tid & 63, r = lane & 31, hi = lane >> 5; const int w = __builtin_amdgcn_readfirstlane(tid >> 6);
    LAS unsigned char* buf = lds + w * 16384; const unsigned bufa = lds0 + (unsigned)w * 16384u;
    LAS float* scr = (LAS float*)(lds + L_SCR + w * 512);
    const float fref = F[(size_t)PAST * 16];
    bf16x8 qr[2][4];
#pragma unroll
    for (int qb = 0; qb < 2; ++qb)
#pragma unroll
        for (int d0 = 0; d0 < 4; ++d0) qr[qb][d0] = *(const bf16x8*)(Qrows + (size_t)(32 * qb + r) * DM + d0 * 16 + hi * 8);
    f32x16 o[2][2]; float mrun[2], lrun[2];
#pragma unroll
    for (int qb = 0; qb < 2; ++qb) { mrun[qb] = -1e30f; lrun[qb] = 0.f;
#pragma unroll
        for (int g = 0; g < 16; ++g) { o[qb][0][g] = 0.f; o[qb][1][g] = 0.f; } }
    const int vrow = lane >> 2, vcol = 8 * (lane & 3);
    for (int j = w; j <= PAST / 64; j += 8) {
        const bool isnew = j == PAST / 64;
        if (isnew) {
            const bf16* kp_ = Kn + (size_t)lane * DM; unsigned kd_ = bufa;
#pragma unroll 1
            for (int c = 0; c < 8; ++c) { glds16(kp_, (unsigned)__builtin_amdgcn_readfirstlane(kd_)); kp_ += 8; kd_ += 1024; }
            const bf16* vp_ = Vn + (size_t)vrow * DM + vcol;
#pragma unroll 1
            for (int pr = 0; pr < 4; ++pr) { glds16(vp_, (unsigned)__builtin_amdgcn_readfirstlane(kd_)); glds16(vp_ + 32, (unsigned)__builtin_amdgcn_readfirstlane(kd_ + 4096)); vp_ += (size_t)16 * DM; kd_ += 1024; }
        } else {
            const int rr = lane >> 2, q4 = lane & 3;
            const float* kf = Kc + ((size_t)64 * j + rr) * DM + 4 * q4; const float* vf_ = Vc + ((size_t)64 * j + rr) * DM + 4 * q4;
#pragma unroll
            for (int ih = 0; ih < 2; ++ih) {
                f32x4 kr[8], vr[8];
#pragma unroll
                for (int i2 = 0; i2 < 2; ++i2)
#pragma unroll
                    for (int jq = 0; jq < 4; ++jq) { const int i = 2 * ih + i2; kr[4 * i2 + jq] = *(const f32x4*)(kf + (size_t)16 * i * DM + 16 * jq); vr[4 * i2 + jq] = *(const f32x4*)(vf_ + (size_t)16 * i * DM + 16 * jq); }
#pragma unroll
                for (int i2 = 0; i2 < 2; ++i2)
#pragma unroll
                    for (int jq = 0; jq < 4; ++jq) { const f32x4 k4 = kr[4 * i2 + jq], v4 = vr[4 * i2 + jq]; const int row = 16 * (2 * ih + i2) + rr;
                        *(LAS v2u*)(buf + (2 * jq + (q4 >> 1)) * 1024 + row * 16 + (q4 & 1) * 8) = (v2u){pk_bf16(k4[0], k4[1]), pk_bf16(k4[2], k4[3])};
                        *(LAS v2u*)(buf + 8192 + (jq >> 1) * 4096 + row * 64 + (jq & 1) * 32 + q4 * 8) = (v2u){pk_bf16(v4[0], v4[1]), pk_bf16(v4[2], v4[3])}; }
            }
        }
        const float fkv = (fref - F[((size_t)64 * j + lane) * 16]) * LOG2E;
        scr[lane] = fkv;
        asm volatile("s_waitcnt vmcnt(0) lgkmcnt(0)" ::: "memory");
        __builtin_amdgcn_sched_barrier(0);
        bf16x8 ka[4], kb[4];
#pragma unroll
        for (int d0 = 0; d0 < 4; ++d0) { ka[d0] = *(const LAS bf16x8*)(buf + hi * 1024 + r * 16 + d0 * 2048); kb[d0] = *(const LAS bf16x8*)(buf + hi * 1024 + r * 16 + d0 * 2048 + 512); }
        const LAS unsigned char* vb = buf + 8192 + ((lane >> 4) & 1) * 32 + (lane & 3) * 8 + (4 * hi + ((lane & 15) >> 2)) * 64;
#pragma unroll
        for (int qb = 0; qb < 2; ++qb) {
            f32x16 p0, p1;
#pragma unroll
            for (int jj = 0; jj < 4; ++jj) { const f32x4 f0 = *(const LAS f32x4*)(scr + 8 * jj + 4 * hi), f1 = *(const LAS f32x4*)(scr + 32 + 8 * jj + 4 * hi);
#pragma unroll
                for (int i = 0; i < 4; ++i) { p0[4 * jj + i] = f0[i]; p1[4 * jj + i] = f1[i]; } }
#pragma unroll
            for (int d0 = 0; d0 < 4; ++d0) { p0 = A3_MFMA(ka[d0], qr[qb][d0], p0); p1 = A3_MFMA(kb[d0], qr[qb][d0], p1); }
            if (isnew) { const int qrel = 32 * qb + r;
#pragma unroll
                for (int g = 0; g < 16; ++g) { const int kv = crow(g, hi); if (kv > qrel) p0[g] = -__builtin_inff(); if (kv + 32 > qrel) p1[g] = -__builtin_inff(); } }
            float rm = fmaxf(p0[0], p1[0]);
#pragma unroll
            for (int g = 1; g < 16; ++g) rm = fmaxf(rm, fmaxf(p0[g], p1[g]));
            rm = fmaxf(rm, __shfl_xor(rm, 32));
            const float mnew = fmaxf(mrun[qb], rm), alpha = __builtin_amdgcn_exp2f(mrun[qb] - mnew); mrun[qb] = mnew;
            float ps = 0.f;
#pragma unroll
            for (int g = 0; g < 16; ++g) { p0[g] = __builtin_amdgcn_exp2f(p0[g] - mnew); p1[g] = __builtin_amdgcn_exp2f(p1[g] - mnew); ps += p0[g] + p1[g]; }
            lrun[qb] = lrun[qb] * alpha + ps;
            if (hi == 0) scr[64 + r] = alpha;
#pragma unroll
            for (int jj = 0; jj < 4; ++jj) { const f32x4 a4 = *(const LAS f32x4*)(scr + 64 + 8 * jj + 4 * hi);
#pragma unroll
                for (int i = 0; i < 4; ++i) { o[qb][0][4 * jj + i] *= a4[i]; o[qb][1][4 * jj + i] *= a4[i]; } }
            const v4u pw0 = (v4u){pk_bf16(p0[0], p0[1]), pk_bf16(p0[2], p0[3]), pk_bf16(p0[4], p0[5]), pk_bf16(p0[6], p0[7])};
            const v4u pw1 = (v4u){pk_bf16(p0[8], p0[9]), pk_bf16(p0[10], p0[11]), pk_bf16(p0[12], p0[13]), pk_bf16(p0[14], p0[15])};
            const v4u pw2 = (v4u){pk_bf16(p1[0], p1[1]), pk_bf16(p1[2], p1[3]), pk_bf16(p1[4], p1[5]), pk_bf16(p1[6], p1[7])};
            const v4u pw3 = (v4u){pk_bf16(p1[8], p1[9]), pk_bf16(p1[10], p1[11]), pk_bf16(p1[12], p1[13]), pk_bf16(p1[14], p1[15])};
#pragma unroll
            for (int d0 = 0; d0 < 2; ++d0) {
                bf16x8 vf[4];
#pragma unroll
                for (int ks = 0; ks < 4; ++ks) { const s16x4 lo = vtr(vb + d0 * 4096 + ks * 1024), hh = vtr(vb + d0 * 4096 + ks * 1024 + 512);
                    vf[ks] = (bf16x8){lo[0], lo[1], lo[2], lo[3], hh[0], hh[1], hh[2], hh[3]}; }
                o[qb][d0] = A3_MFMA(__builtin_bit_cast(bf16x8, pw0), vf[0], o[qb][d0]); o[qb][d0] = A3_MFMA(__builtin_bit_cast(bf16x8, pw1), vf[1], o[qb][d0]);
                o[qb][d0] = A3_MFMA(__builtin_bit_cast(bf16x8, pw2), vf[2], o[qb][d0]); o[qb][d0] = A3_MFMA(__builtin_bit_cast(bf16x8, pw3), vf[3], o[qb][d0]);
            }
        }
        asm volatile("s_waitcnt lgkmcnt(0)" ::: "memory");
        __builtin_amdgcn_sched_barrier(0);
    }
#pragma unroll
    for (int qb = 0; qb < 2; ++qb) {
        lrun[qb] += __shfl_xor(lrun[qb], 32);
#pragma unroll
        for (int g = 0; g < 16; ++g)
#pragma unroll
            for (int d0 = 0; d0 < 2; ++d0) *(LAS float*)(buf + (32 * qb + crow(g, hi)) * 256 + (32 * d0 + r) * 4) = o[qb][d0][g];
        if (hi == 0) { scr[32 * qb + r] = mrun[qb]; scr[64 + 32 * qb + r] = lrun[qb]; }
    }
    __syncthreads();
    {
        const int row = tid >> 3, dg = tid & 7; float mw[8], M_ = -1e30f;
#pragma unroll
        for (int ww = 0; ww < 8; ++ww) { mw[ww] = *(const LAS float*)(lds + L_SCR + ww * 512 + row * 4); M_ = fmaxf(M_, mw[ww]); }
        float Lsum = 0.f; f32x4 a0 = (f32x4){0.f, 0.f, 0.f, 0.f}, a1 = a0;
#pragma unroll
        for (int ww = 0; ww < 8; ++ww) { const float sc = __builtin_amdgcn_exp2f(mw[ww] - M_); Lsum += sc * *(const LAS float*)(lds + L_SCR + ww * 512 + 256 + row * 4);
            const f32x4 x0 = *(const LAS f32x4*)(lds + ww * 16384 + row * 256 + dg * 32), x1 = *(const LAS f32x4*)(lds + ww * 16384 + row * 256 + dg * 32 + 16);
            a0 += x0 * sc; a1 += x1 * sc; }
        const float rl = __builtin_amdgcn_rcpf(Lsum); const size_t go = (size_t)row * DM + 8 * dg; const v4u gg = *(const v4u*)(Grows + go);
        v4u ov; ov.x = pk_bf16(a0[0] * rl * bf_lo(gg.x), a0[1] * rl * bf_hi(gg.x)); ov.y = pk_bf16(a0[2] * rl * bf_lo(gg.y), a0[3] * rl * bf_hi(gg.y));
        ov.z = pk_bf16(a1[0] * rl * bf_lo(gg.z), a1[1] * rl * bf_hi(gg.z)); ov.w = pk_bf16(a1[2] * rl * bf_lo(gg.w), a1[3] * rl * bf_hi(gg.w));
        *(v4u*)(Orows + go) = ov;
    }
    __syncthreads();
}
#undef A3_MFMA
}

namespace sg {
enum { IN = 0, RES = 1, UP = 2, KVQ = 3 };
struct P {
    const bf16* A; const bf16* Bt; int K, N;
    const float* rss; int rss_parts;
    const float* lb;
    bf16* o0; float* rss_out; float* out;
};
constexpr int SG_STAGE = 24576, SG_NS = 4, SG_RED = SG_NS * SG_STAGE;
__device__ __forceinline__ void glds16(const void* gsrc, unsigned lds_dst) { unsigned keep;
    asm volatile("s_mov_b32 %0, m0\n\ts_mov_b32 m0, %2\n\ts_nop 0\n\tglobal_load_lds_dwordx4 %1, off\n\ts_mov_b32 m0, %0" : "=&s"(keep) : "v"(gsrc), "s"(lds_dst) : "memory"); }
template <int MODE> __device__ __forceinline__ void phase(LAS unsigned char* lds, unsigned lds0, const P& p, int vcu, int G) {
    const int tid = threadIdx.x, lane = tid & 63, r = lane & 31, hi = lane >> 5; const int w = __builtin_amdgcn_readfirstlane(tid >> 6);
    const int nh = w & 1, kq = w >> 1, nct = p.N >> 6, nblk = p.K >> 7, ntile = 16 * nct;
    LAS float* red = (LAS float*)(lds + SG_RED);
    if (vcu >= ntile) return;
    const int mytiles = (ntile - vcu + G - 1) / G, NB = mytiles * nblk;
    const int lr = lane >> 4, sl = lane & 15;
    const int arow = 4 * w + lr, brow0 = 4 * w + lr, brow1 = 32 + 4 * w + lr;
    const int acol = ((sl ^ (arow & 15)) << 3), bcol0 = ((sl ^ (brow0 & 15)) << 3), bcol1 = ((sl ^ (brow1 & 15)) << 3);
#define SG_DMA(n_) do { const int ti_ = (n_) / nblk, bk_ = (n_) - ti_ * nblk, tt_ = vcu + ti_ * G, rt_ = tt_ & 15, ct_ = tt_ >> 4; const unsigned st_ = lds0 + (unsigned)(((n_) & (SG_NS - 1)) * SG_STAGE); \
        glds16(p.A + (size_t)(MP + 32 * rt_ + arow) * p.K + bk_ * 128 + acol, (unsigned)__builtin_amdgcn_readfirstlane(st_ + w * 1024)); \
        glds16(p.Bt + (size_t)(64 * ct_ + brow0) * p.K + bk_ * 128 + bcol0, (unsigned)__builtin_amdgcn_readfirstlane(st_ + 8192 + w * 1024)); \
        glds16(p.Bt + (size_t)(64 * ct_ + brow1) * p.K + bk_ * 128 + bcol1, (unsigned)__builtin_amdgcn_readfirstlane(st_ + 16384 + w * 1024)); } while (0)
    SG_DMA(0); if (NB > 1) SG_DMA(1); if (NB > 2) SG_DMA(2);
    f32x16 acc;
#pragma unroll
    for (int g = 0; g < 16; ++g) acc[g] = 0.f;
    const int fa0 = r * 256 + (((4 * kq + hi) ^ (r & 15)) << 4), fa1 = r * 256 + (((4 * kq + 2 + hi) ^ (r & 15)) << 4);
    int n = 0, t = vcu;
    for (;;) {
        const int rt = t & 15, ct = t >> 4, row0 = MP + 32 * rt, col0 = 64 * ct;
        const int g0 = 2 * w, rowA = row0 + crow(g0, hi), rowB = row0 + crow(g0 + 1, hi), c0 = col0 + r, c1 = c0 + 32;
        float ssA = 0.f, ssB = 0.f; f32x4 pa[4], pb[4]; unsigned short xo[4];
        {
            if (MODE == RES) { const bf16* xa = p.o0 + (size_t)rowA * 1024; const bf16* xb = p.o0 + (size_t)rowB * 1024; xo[0] = xa[c0]; xo[1] = xa[c1]; xo[2] = xb[c0]; xo[3] = xb[c1]; }
            else if (p.rss_parts == 1) { ssA = p.rss[rowA]; ssB = p.rss[rowB]; }
            else { const f32x4* qa = (const f32x4*)(p.rss + (size_t)rowA * 16); const f32x4* qb = (const f32x4*)(p.rss + (size_t)rowB * 16);
#pragma unroll
                for (int q = 0; q < 4; ++q) { pa[q] = qa[q]; pb[q] = qb[q]; } }
        }
        for (int bk = 0; bk < nblk; ++bk, ++n) {
            if (n + 2 < NB) asm volatile("s_waitcnt vmcnt(6) lgkmcnt(0)\n\ts_barrier" ::: "memory");
            else if (n + 1 < NB) asm volatile("s_waitcnt vmcnt(3) lgkmcnt(0)\n\ts_barrier" ::: "memory");
            else asm volatile("s_waitcnt vmcnt(0) lgkmcnt(0)\n\ts_barrier" ::: "memory");
            if (n + 3 < NB) SG_DMA(n + 3);
            const LAS unsigned char* st = lds + (n & (SG_NS - 1)) * SG_STAGE;
            const bf16x8 a0 = *(const LAS bf16x8*)(st + fa0), a1 = *(const LAS bf16x8*)(st + fa1);
            const bf16x8 b0 = *(const LAS bf16x8*)(st + 8192 + nh * 8192 + fa0), b1 = *(const LAS bf16x8*)(st + 8192 + nh * 8192 + fa1);
            acc = __builtin_amdgcn_mfma_f32_32x32x16_bf16(a0, b0, acc, 0, 0, 0);
            acc = __builtin_amdgcn_mfma_f32_32x32x16_bf16(a1, b1, acc, 0, 0, 0);
        }
#pragma unroll
        for (int g = 0; g < 16; ++g) { red[(w * 16 + g) * 64 + lane] = acc[g]; acc[g] = 0.f; }
        asm volatile("s_waitcnt lgkmcnt(0)\n\ts_barrier" ::: "memory");
#pragma unroll
        for (int gi = 0; gi < 2; ++gi) {
            const int g = g0 + gi; float v0 = 0.f, v1 = 0.f;
#pragma unroll
            for (int q = 0; q < 4; ++q) { v0 += red[((2 * q) * 16 + g) * 64 + lane]; v1 += red[((2 * q + 1) * 16 + g) * 64 + lane]; }
            const int row = gi ? rowB : rowA;
            float rs = 1.f;
            if (MODE != RES) {
                float ss;
                if (p.rss_parts == 1) ss = gi ? ssB : ssA;
                else { const f32x4 a0 = gi ? pb[0] : pa[0], a1 = gi ? pb[1] : pa[1], a2 = gi ? pb[2] : pa[2], a3 = gi ? pb[3] : pa[3];
                    ss = (((a0[0] + a0[1]) + (a0[2] + a0[3])) + ((a1[0] + a1[1]) + (a1[2] + a1[3]))) + (((a2[0] + a2[1]) + (a2[2] + a2[3])) + ((a3[0] + a3[1]) + (a3[2] + a3[3]))); }
                rs = rsqrtf(ss * (1.0f / 1024.0f) + EPS);
            }
            const float z0 = v0 * rs, z1 = v1 * rs;
#define SG_ST(ptr, val) *(ptr) = (unsigned short)(pk_bf16((val), 0.f) & 0xffffu)
            if (MODE == IN) {
                const int seg = col0 >> 10, cc0 = c0 & 1023, cc1 = c1 & 1023; const size_t ro = (size_t)row * 1024;
                if (seg == 1) { const float l0 = p.lb[cc0], l1 = p.lb[cc1], s0 = sigmoidf_(z0), s1 = sigmoidf_(z1);
                    SG_ST(p.o0 + pg8::SLAB_ELEMS + ro + cc0, (1.f - l0) * (1.f - s0)); SG_ST(p.o0 + pg8::SLAB_ELEMS + ro + cc1, (1.f - l1) * (1.f - s1));
                    SG_ST(p.o0 + 2 * pg8::SLAB_ELEMS + ro + cc0, __logf(l0 + (1.f - l0) * s0)); SG_ST(p.o0 + 2 * pg8::SLAB_ELEMS + ro + cc1, __logf(l1 + (1.f - l1) * s1)); }
                else { bf16* o = p.o0 + (size_t)(seg == 0 ? 0 : seg == 2 ? 3 : 4) * pg8::SLAB_ELEMS + ro;
                    SG_ST(o + cc0, seg == 2 ? z0 : (seg == 0 ? z0 * sigmoidf_(z0) : sigmoidf_(z0))); SG_ST(o + cc1, seg == 2 ? z1 : (seg == 0 ? z1 * sigmoidf_(z1) : sigmoidf_(z1))); }
            } else if (MODE == RES) {
                bf16* xp = p.o0 + (size_t)row * 1024; const float x0 = bf2f(xo[2 * gi]) + v0, x1 = bf2f(xo[2 * gi + 1]) + v1;
                SG_ST(xp + c0, x0); SG_ST(xp + c1, x1);
                float sq = x0 * x0 + x1 * x1; sq += __shfl_xor(sq, 1); sq += __shfl_xor(sq, 2); sq += __shfl_xor(sq, 4); sq += __shfl_xor(sq, 8); sq += __shfl_xor(sq, 16);
                if (r == 0) p.rss_out[(size_t)row * 16 + ct] = sq;
            } else if (MODE == UP) {
                bf16* o = p.o0 + (size_t)row * 4096; const float h0 = fmaxf(z0, 0.f), h1 = fmaxf(z1, 0.f);
                SG_ST(o + c0, h0 * h0); SG_ST(o + c1, h1 * h1);
            } else {
                const int seg = col0 >> 10, cc0 = c0 & 1023, cc1 = c1 & 1023; const size_t ro = (size_t)row * 1024;
                bf16* o = p.o0 + (size_t)seg * pg8::SLAB_ELEMS + ro;
                if (seg < 2) { SG_ST(o + cc0, z0); SG_ST(o + cc1, z1); float* fo = p.out + (seg == 0 ? OK_S : OV_S) + (size_t)(row - MP) * 1024; fo[cc0] = z0; fo[cc1] = z1; }
                else if (seg == 2) { SG_ST(o + cc0, z0 * QSCALE); SG_ST(o + cc1, z1 * QSCALE); }
                else { SG_ST(o + cc0, sigmoidf_(z0)); SG_ST(o + cc1, sigmoidf_(z1)); }
            }
#undef SG_ST
        }
        asm volatile("s_waitcnt lgkmcnt(0)\n\ts_barrier" ::: "memory");
        t += G; if (t >= ntile) break;
    }
    __syncthreads();
#undef SG_DMA
}
}

constexpr int NWAVES = 8;
#ifndef MK_N_LAUNCHES
#define MK_N_LAUNCHES 1
#endif
constexpr int N_PHASES = 13;
constexpr int N_LAUNCHES = MK_N_LAUNCHES;

struct Args {
    const float* in[21]; float* out_; unsigned char* ws_; int ph_lo, ph_hi, dry_gla, pad;
};

__device__ __forceinline__ void p0_transpose_item(const float* W, int K, int ldw, int nblk, const float* gain, bf16* WT, int row_off, LAS float* scr, int item, int lane) {
    const int kb = item / nblk, nb = item % nblk, k0 = 64 * kb, n0 = 32 * nb;
    {
        const int rg = lane >> 3, c4 = lane & 7; f32x4 v[8]; float gs[8];
#pragma unroll
        for (int i = 0; i < 8; ++i) { const int kk = 8 * i + rg; v[i] = *(const f32x4*)(W + (size_t)(k0 + kk) * ldw + n0 + 4 * c4); gs[i] = gain ? gain[k0 + kk] : 1.0f; }
#pragma unroll
        for (int i = 0; i < 8; ++i) { const int kk = 8 * i + rg; LAS float* d = scr + kk * 33 + 4 * c4; d[0] = v[i][0] * gs[i]; d[1] = v[i][1] * gs[i]; d[2] = v[i][2] * gs[i]; d[3] = v[i][3] * gs[i]; }
    }
    LDS_WAIT(); asm volatile("" ::: "memory");
    const int c = lane & 7;
#pragma unroll
    for (int j = 0; j < 4; ++j) { const int n = (lane >> 3) + 8 * j; const LAS float* s = scr + (8 * c) * 33 + n;
        v4u o; o.x = pk_bf16(s[0 * 33], s[1 * 33]); o.y = pk_bf16(s[2 * 33], s[3 * 33]); o.z = pk_bf16(s[4 * 33], s[5 * 33]); o.w = pk_bf16(s[6 * 33], s[7 * 33]);
        *(v4u*)(WT + (size_t)(row_off + n0 + n) * K + k0 + 8 * c) = o; }
    LDS_WAIT(); asm volatile("" ::: "memory");
}

__global__ void __launch_bounds__(NWAVES * 64, 2) yoco_fwd(Args args) {
    extern __shared__ __attribute__((aligned(16))) unsigned char lds_raw[];
    LAS unsigned char* lds = (LAS unsigned char*)lds_raw;
    volatile LAS unsigned* MISC = (volatile LAS unsigned*)(lds + MISC_OFF);
    const int tid = threadIdx.x, lane = tid & 63; const int wave = __builtin_amdgcn_readfirstlane(tid >> 6);
    const int G = gridDim.x, bx = blockIdx.x;
    const int vcu = (G % 8 == 0) ? (bx % 8) * (G / 8) + bx / 8 : bx;
    const int gw = vcu * NWAVES + wave, NGW = G * NWAVES;
#define ws (args.ws_)
#define out (args.out_)
#define ctl ((gu32*)(args.ws_ + WS_CTL))
#define lbv ((float*)(ws + WS_LB))
#define Wlf_t ((bf16*)(ws + WS_WLF))
#define rssx ((float*)(ws + WS_RSSX))
#define rssA ((float*)(ws + WS_RSSA))
#define rssB ((float*)(ws + WS_RSSB))
#define Fs ((float*)(ws + WS_FS))
#define Win_t ((bf16*)(ws + WS_WIN))
#define Wo_t ((bf16*)(ws + WS_WO))
#define Wup0_t ((bf16*)(ws + WS_WUP0))
#define Wdn0_t ((bf16*)(ws + WS_WDN0))
#define Wkvq_t ((bf16*)(ws + WS_WKVQ))
#define Wob_t ((bf16*)(ws + WS_WOB))
#define Wup1_t ((bf16*)(ws + WS_WUP1))
#define Wdn1_t ((bf16*)(ws + WS_WDN1))
#define XB ((bf16*)(ws + WS_SLAB0))
#define S1 ((bf16*)(ws + WS_SLAB0 + SLAB))
#define S2 ((bf16*)(ws + WS_SLAB0 + 2 * SLAB))
#define S3 ((bf16*)(ws + WS_SLAB0 + 3 * SLAB))
#define S4 ((bf16*)(ws + WS_SLAB0 + 4 * SLAB))
#define S5 ((bf16*)(ws + WS_SLAB0 + 5 * SLAB))
    LAS float* tabs = (LAS float*)(lds + TAB_OFF);

    for (int u = tid; u < 64; u += NWAVES * 64) ((LAS unsigned*)(lds + MISC_OFF))[u] = 0u;
    __syncthreads();
    XcdBarrier bar; bar.bar = (unsigned*)(ctl + CW_BAR); bar.x = 0; bar.st = nullptr;
    if (N_LAUNCHES == 1) bar = xcd_barrier_post((unsigned*)(ctl + CW_BAR), MISC + 8);
#define GRID_BAR() do { if (N_LAUNCHES == 1) xcd_barrier(bar); } while (0)
    const int lo = args.ph_lo, hi_ph = args.ph_hi;
#ifndef PHASE_MASK
#define PHASE_MASK 0x1fff
#endif
#define IN(k) (((PHASE_MASK >> (k)) & 1) && lo <= (k) && (k) < hi_ph)
#define SEAM(k) do { if (IN(k) && IN((k) + 1)) GRID_BAR(); } while (0)

    if (IN(0)) {
        LAS float* scr = (LAS float*)(lds + wave * 16384);
        constexpr int I_IN = 16 * 128, I_O = 16 * 32;
        for (int it = gw; it < I_IN + I_O; it += NGW) {
            if (it < I_IN) p0_transpose_item(args.in[7], 1024, 4096, 128, args.in[6], Win_t, 0, scr, it, lane);
            else p0_transpose_item(args.in[10], 1024, 1024, 32, nullptr, Wo_t, 0, scr, it - I_IN, lane);
        }
        const int gt = gw * 64 + lane, NGT = NGW * 64;
        for (int c = gt; c < 1024; c += NGT) lbv[c] = 1.0f / (1.0f + __expf(args.in[8][1024 + c] - args.in[8][c]));
        for (int m0 = gw; m0 < M; m0 += 4 * NGW) {
            f32x4 v[4][4];
#pragma unroll
            for (int u = 0; u < 4; ++u) { const int m = m0 + u * NGW; if (m < M) { const f32x4* xr = (const f32x4*)(m < MP ? args.in[0] + (size_t)m * DM : args.in[1] + (size_t)(m - MP) * DM) + lane;
#pragma unroll
                for (int j = 0; j < 4; ++j) v[u][j] = xr[64 * j]; } }
#pragma unroll
            for (int u = 0; u < 4; ++u) { const int m = m0 + u * NGW; if (m < M) { float s = 0.f;
#pragma unroll
                for (int j = 0; j < 4; ++j) s += (v[u][j][0] * v[u][j][0] + v[u][j][1] * v[u][j][1]) + (v[u][j][2] * v[u][j][2] + v[u][j][3] * v[u][j][3]);
                s = wave_sum(s); if (lane == 0) rssx[m] = s;
                v2u* o8 = (v2u*)(XB + (size_t)m * DM) + lane;
#pragma unroll
                for (int j = 0; j < 4; ++j) o8[64 * j] = (v2u){pk_bf16(v[u][j][0], v[u][j][1]), pk_bf16(v[u][j][2], v[u][j][3])}; } }
        }
    }
    SEAM(0);
    if (IN(1)) {
        { sg::P sp{XB, Win_t, 1024, 4096, rssx, 1, lbv, S1, nullptr, out}; sg::phase<sg::IN>(lds, (unsigned)(uintptr_t)lds_raw, sp, vcu, G); }
        pg8::Gemm g{XB, Win_t, MP, 4096, 1024}; pg8::StaticOrder S; S.init(MP, 4096, G, bx);
        pg8::EpiIn E{rssx, lbv, S1};
        pg8::gemm_phase<pg8::EpiIn, pg8::StaticOrder, true, true>(lds, tabs, g, S, E);
    }
    SEAM(1);
    if (IN(2)) {
        if (bx >= 192) {
            LAS float* scr = (LAS float*)(lds + wave * 16384);
            constexpr int I_UP = 16 * 128, I_DN = 64 * 32, I_KV = 16 * 64, I_Q = 16 * 64, I_O = 16 * 32;
            constexpr int NITEMS = I_UP + I_DN + I_KV + I_Q + I_O + I_UP + I_DN;
            const int xw = (bx - 192) * NWAVES + wave, NXW = (G - 192) * NWAVES;
            for (int it = xw; it < NITEMS; it += NXW) {
                int r = it;
                if (r < I_UP) { p0_transpose_item(args.in[18], 1024, 4096, 128, args.in[17], Wup0_t, 0, scr, r, lane); continue; } r -= I_UP;
                if (r < I_DN) { p0_transpose_item(args.in[19], 4096, 1024, 32, nullptr, Wdn0_t, 0, scr, r, lane); continue; } r -= I_DN;
                if (r < I_KV) { p0_transpose_item(args.in[12], 1024, 2064, 64, args.in[11], Wkvq_t, 0, scr, r, lane); continue; } r -= I_KV;
                if (r < I_Q)  { p0_transpose_item(args.in[15], 1024, 2048, 64, args.in[14], Wkvq_t, 2048, scr, r, lane); continue; } r -= I_Q;
                if (r < I_O)  { p0_transpose_item(args.in[16], 1024, 1024, 32, nullptr, Wob_t, 0, scr, r, lane); continue; } r -= I_O;
                if (r < I_UP) { p0_transpose_item(args.in[18] + (size_t)1024 * 4096, 1024, 4096, 128, args.in[17] + 1024, Wup1_t, 0, scr, r, lane); continue; } r -= I_UP;
                p0_transpose_item(args.in[19] + (size_t)4096 * 1024, 4096, 1024, 32, nullptr, Wdn1_t, 0, scr, r, lane);
            }
            for (int e = xw * 64 + lane; e < 16 * 1024; e += NXW * 64) { const int n = e >> 10, k = e & 1023; Wlf_t[e] = (unsigned short)(pk_bf16(args.in[12][(size_t)k * 2064 + 2048 + n] * args.in[11][k], 0.f) & 0xffffu); }
        }
        for (int u = bx; u < 192; u += G) {
            const bool smp = u >= 128; const int b = smp ? (u - 128) >> 3 : u >> 3, h = u & 7;
            const float* s0 = smp ? args.in[2] + (size_t)(b * HA + h) * KA * KA : nullptr;
            float* sfin = out + (smp ? OST_S : OST_P) + (size_t)(b * HA + h) * KA * KA;
            gla::unit(lds, S1, args.dry_gla ? (bf16*)(ws + 470 * MiB) : S1, args.dry_gla ? 16383 : -1, S2, S3, S4, S5, args.in[9], smp ? MP + b * TS : b * TP, smp ? 1 : TP / CH, h, s0, sfin);
        }
    }
    SEAM(2);
    if (IN(3)) {
        { sg::P sp{S1, Wo_t, 1024, 1024, nullptr, 1, nullptr, XB, rssA, out}; sg::phase<sg::RES>(lds, (unsigned)(uintptr_t)lds_raw, sp, vcu, G); }
        pg8::Gemm g{S1, Wo_t, MP, 1024, 1024}; pg8::StaticOrder S; S.init(MP, 1024, G, bx);
        pg8::EpiRes E{XB, rssA};
        pg8::gemm_phase<pg8::EpiRes, pg8::StaticOrder, true, true>(lds, tabs, g, S, E);
    }
    SEAM(3);
    if (IN(4)) {
        { sg::P sp{XB, Wup0_t, 1024, 4096, rssA, 16, nullptr, S2, nullptr, out}; sg::phase<sg::UP>(lds, (unsigned)(uintptr_t)lds_raw, sp, vcu, G);
#ifdef PROBE_SG
          sg::phase<sg::UP>(lds, (unsigned)(uintptr_t)lds_raw, sp, vcu, G); sg::phase<sg::UP>(lds, (unsigned)(uintptr_t)lds_raw, sp, vcu, G); sg::phase<sg::UP>(lds, (unsigned)(uintptr_t)lds_raw, sp, vcu, G); sg::phase<sg::UP>(lds, (unsigned)(uintptr_t)lds_raw, sp, vcu, G);
#endif
        }
        pg8::Gemm g{XB, Wup0_t, MP, 4096, 1024}; pg8::StaticOrder S; S.init(MP, 4096, G, bx);
        pg8::EpiUp E{rssA, S2};
        pg8::gemm_phase<pg8::EpiUp, pg8::StaticOrder, true, true>(lds, tabs, g, S, E);
    }
    SEAM(4);
    if (IN(5)) {
        { sg::P sp{S2, Wdn0_t, 4096, 1024, nullptr, 1, nullptr, XB, rssB, out}; sg::phase<sg::RES>(lds, (unsigned)(uintptr_t)lds_raw, sp, vcu, G); }
        pg8::Gemm g{S2, Wdn0_t, MP, 1024, 4096}; pg8::StaticOrder S; S.init(MP, 1024, G, bx);
        pg8::EpiRes E{XB, rssB};
        pg8::gemm_phase<pg8::EpiRes, pg8::StaticOrder, true, true>(lds, tabs, g, S, E);
    }
    SEAM(5);
    if (IN(6)) {
        for (int rb = gw; rb < MP / 16; rb += NGW) {
            const int arow = 16 * rb + (lane & 15), kq = lane >> 4;
            const bf16* ap = XB + (size_t)arow * DM + 8 * kq; const bf16* bp = Wlf_t + (size_t)(lane & 15) * DM + 8 * kq;
            f32x4 acc = (f32x4){0.f, 0.f, 0.f, 0.f};
#pragma unroll 16
            for (int ks = 0; ks < 32; ++ks) { const bf16x8 a = *(const bf16x8*)(ap + 32 * ks), b = *(const bf16x8*)(bp + 32 * ks); acc = __builtin_amdgcn_mfma_f32_16x16x32_bf16(a, b, acc, 0, 0, 0); }
            const int col = lane & 15; const float bias = args.in[13][col];
#pragma unroll
            for (int i = 0; i < 4; ++i) { const int row = 16 * rb + 4 * kq + i;
                const f32x4* pp = (const f32x4*)(rssB + (size_t)row * 16); const f32x4 p0 = pp[0], p1 = pp[1], p2 = pp[2], p3 = pp[3];
                const float ss = (((p0[0] + p0[1]) + (p0[2] + p0[3])) + ((p1[0] + p1[1]) + (p1[2] + p1[3]))) + (((p2[0] + p2[1]) + (p2[2] + p2[3])) + ((p3[0] + p3[1]) + (p3[2] + p3[3])));
                const float z = acc[i] * rsqrtf(ss * (1.0f / 1024.0f) + EPS) + bias;
                out[OLF_P + (size_t)row * 16 + col] = z < 0.f ? z - log1pf(expf(z)) : -log1pf(expf(-z)); }
        }
        for (int d = gw; d < MS * HB; d += NGW) {
            const int row = MP + (d >> 4), col = d & 15;
            const v4u xa = *((const v4u*)(XB + (size_t)row * DM) + lane), xb = *((const v4u*)(XB + (size_t)row * DM) + 64 + lane);
            const v4u wa = *((const v4u*)(Wlf_t + (size_t)col * DM) + lane), wb = *((const v4u*)(Wlf_t + (size_t)col * DM) + 64 + lane);
            float s = bf_lo(xa.x) * bf_lo(wa.x) + bf_hi(xa.x) * bf_hi(wa.x) + bf_lo(xa.y) * bf_lo(wa.y) + bf_hi(xa.y) * bf_hi(wa.y) + bf_lo(xa.z) * bf_lo(wa.z) + bf_hi(xa.z) * bf_hi(wa.z) + bf_lo(xa.w) * bf_lo(wa.w) + bf_hi(xa.w) * bf_hi(wa.w)
                    + bf_lo(xb.x) * bf_lo(wb.x) + bf_hi(xb.x) * bf_hi(wb.x) + bf_lo(xb.y) * bf_lo(wb.y) + bf_hi(xb.y) * bf_hi(wb.y) + bf_lo(xb.z) * bf_lo(wb.z) + bf_hi(xb.z) * bf_hi(wb.z) + bf_lo(xb.w) * bf_lo(wb.w) + bf_hi(xb.w) * bf_hi(wb.w);
            s = wave_sum(s);
            float ssp = rssB[(size_t)row * 16 + (lane & 15)]; ssp += __shfl_xor(ssp, 1); ssp += __shfl_xor(ssp, 2); ssp += __shfl_xor(ssp, 4); ssp += __shfl_xor(ssp, 8);
            const float z = s * rsqrtf(ssp * (1.0f / 1024.0f) + EPS) + args.in[13][col];
            if (lane == 0) out[OLF_S + (size_t)(row - MP) * 16 + col] = z < 0.f ? z - log1pf(expf(z)) : -log1pf(expf(-z));
        }
        { sg::P sp{XB, Wkvq_t, 1024, 4096, rssB, 16, nullptr, S1, nullptr, out}; sg::phase<sg::KVQ>(lds, (unsigned)(uintptr_t)lds_raw, sp, vcu, G); }
        pg8::Gemm g{XB, Wkvq_t, MP, 4096, 1024}; pg8::StaticOrder S; S.init(MP, 4096, G, bx);
        pg8::EpiKvq E{rssB, S1, out, QSCALE};
        pg8::gemm_phase<pg8::EpiKvq, pg8::StaticOrder, true, true>(lds, tabs, g, S, E);
    }
    SEAM(6);
    if (IN(7)) {
        if (bx >= BP + BS) {
            const int NE = (G - (BP + BS)) * NWAVES * 64, e0 = (bx - (BP + BS)) * NWAVES * 64 + tid; constexpr int NV = MP * 128;
            for (int e = e0; e < 2 * NV; e += 8 * NE) { v4u xv[8];
#pragma unroll
                for (int u = 0; u < 8; ++u) { const int ee = e + u * NE; if (ee < 2 * NV) xv[u] = ((const v4u*)(ee < NV ? S1 : S2))[ee < NV ? ee : ee - NV]; }
#pragma unroll
                for (int u = 0; u < 8; ++u) { const int ee = e + u * NE; if (ee < 2 * NV) { const v4u x = xv[u]; f32x4* d = (f32x4*)(out + (ee < NV ? OK_P : OV_P)) + (size_t)(ee < NV ? ee : ee - NV) * 2;
                    d[0] = (f32x4){bf_lo(x.x), bf_hi(x.x), bf_lo(x.y), bf_hi(x.y)}; d[1] = (f32x4){bf_lo(x.z), bf_hi(x.z), bf_lo(x.w), bf_hi(x.w)}; } }
            }
        }
        LAS f32x4* segsum = (LAS f32x4*)lds;
        for (int task = bx; task < BP + BS; task += G) {
            const bool smp = task >= BP; const int b = smp ? task - BP : task, nitems = smp ? (SKV / 16) * 4 : (TP / 16) * 4;
#define P7_SRC(seg_, i_) (smp ? (16 * (seg_) + (i_) < PAST ? (const f32x4*)(args.in[5] + ((size_t)b * PAST + 16 * (seg_) + (i_)) * 16) : (const f32x4*)(out + OLF_S + (size_t)(b * TS + 16 * (seg_) + (i_) - PAST) * 16)) \
                              : (const f32x4*)(out + OLF_P + (size_t)(b * TP + 16 * (seg_) + (i_)) * 16))
            for (int it = tid; it < nitems; it += NWAVES * 64) { const int hg = it & 3, seg = it >> 2; f32x4 v[16];
#pragma unroll
                for (int i = 0; i < 16; ++i) v[i] = P7_SRC(seg, i)[hg];
                f32x4 s4 = v[0];
#pragma unroll
                for (int i = 1; i < 16; ++i) s4 += v[i];
                segsum[it] = s4; }
            __syncthreads();
            for (int it = tid; it < nitems; it += NWAVES * 64) { const int hg = it & 3, seg = it >> 2; f32x4 v[16];
#pragma unroll
                for (int i = 0; i < 16; ++i) v[i] = P7_SRC(seg, i)[hg];
                f32x4 run = (f32x4){0.f, 0.f, 0.f, 0.f};
                for (int q = 0; q < seg; ++q) run += segsum[q * 4 + hg];
                if (smp) { f32x4* dstF = (f32x4*)(Fs + ((size_t)b * SKV + 16 * seg) * 16) + hg;
#pragma unroll
                    for (int i = 0; i < 16; ++i) { run += v[i]; dstF[i * 4] = run; }
                } else {
                    f32x4 te = run;
                    for (int q = seg; q <= (seg | 3); ++q) te += segsum[q * 4 + hg];
#pragma unroll
                    for (int i = 0; i < 16; ++i) { run += v[i];
#pragma unroll
                        for (int k = 0; k < 4; ++k) { const float fr = (te[k] - run[k]) * LOG2E; const unsigned fh = pk_bf16(fr, 0.f) & 0xffffu;
                            ((unsigned*)(ws + WS_FKP))[(size_t)(b * HB + 4 * hg + k) * TP + 16 * seg + i] = fh | (pk_bf16(fr - __uint_as_float(fh << 16), 0.f) << 16); } }
                    if ((seg & 3) == 3) {
#pragma unroll
                        for (int k = 0; k < 4; ++k) ((float*)(ws + WS_CEND))[(b * HB + 4 * hg + k) * (TP / 64) + (seg >> 2)] = te[k] * LOG2E; }
                }
            }
#undef P7_SRC
            __syncthreads();
        }
    }
    SEAM(7);
    if (IN(8)) {
        volatile LAS int* qslot = (volatile LAS int*)(lds + MISC_OFF + 128);
        gu32* qhead = ctl + CW_ATT;
        if (tid == 0) qslot[0] = (int)__hip_atomic_fetch_add(qhead, 1u, RLX_AGENT);
        __syncthreads();
        int L = __builtin_amdgcn_readfirstlane(qslot[0]);
        while (L < 128 + 2048) {
            int pre = 0;
            if (tid == 0) pre = (int)__hip_atomic_fetch_add(qhead, 1u, RLX_AGENT);
            if (L < 128) { const int b = L >> 4, h = L & 15; const size_t qo = (size_t)(MP + b * TS) * DM + h * DH;
#ifndef NO_ATT3
                att3::unit(lds, (unsigned)(uintptr_t)lds_raw, S3 + qo, S4 + qo, S5 + qo, args.in[3] + (size_t)b * PAST * DM + h * DH, args.in[4] + (size_t)b * PAST * DM + h * DH, S1 + qo, S2 + qo, Fs + (size_t)b * SKV * 16 + h);
#endif
            } else { const int Lp = L - 128, qb = 7 - (Lp >> 8), b = (Lp >> 4) & 15, h = Lp & 15;
#ifndef NO_ATT2
                att2::attn_unit<8>(b, h, qb, S3, S1, S2, S4, S5, (const unsigned*)(ws + WS_FKP) + (size_t)(b * HB + h) * TP, (const float*)(ws + WS_CEND) + (b * HB + h) * (TP / 64), (char*)lds_raw);
#endif
            }
            if (tid == 0) qslot[0] = pre;
            __syncthreads();
            L = __builtin_amdgcn_readfirstlane(qslot[0]);
            __syncthreads();
        }
    }
    SEAM(8);
    if (IN(9)) {
        { sg::P sp{S5, Wob_t, 1024, 1024, nullptr, 1, nullptr, XB, rssA, out}; sg::phase<sg::RES>(lds, (unsigned)(uintptr_t)lds_raw, sp, vcu, G); }
        pg8::Gemm g{S5, Wob_t, MP, 1024, 1024}; pg8::StaticOrder S; S.init(MP, 1024, G, bx);
        pg8::EpiRes E{XB, rssA};
        pg8::gemm_phase<pg8::EpiRes, pg8::StaticOrder, true, true>(lds, tabs, g, S, E);
    }
    SEAM(9);
    if (IN(10)) {
        { sg::P sp{XB, Wup1_t, 1024, 4096, rssA, 16, nullptr, S1, nullptr, out}; sg::phase<sg::UP>(lds, (unsigned)(uintptr_t)lds_raw, sp, vcu, G); }
        pg8::Gemm g{XB, Wup1_t, MP, 4096, 1024}; pg8::StaticOrder S; S.init(MP, 4096, G, bx);
        pg8::EpiUp E{rssA, S1};
        pg8::gemm_phase<pg8::EpiUp, pg8::StaticOrder, true, true>(lds, tabs, g, S, E);
    }
    SEAM(10);
    if (IN(11)) {
        { sg::P sp{S1, Wdn1_t, 4096, 1024, nullptr, 1, nullptr, XB, rssB, out}; sg::phase<sg::RES>(lds, (unsigned)(uintptr_t)lds_raw, sp, vcu, G); }
        pg8::Gemm g{S1, Wdn1_t, MP, 1024, 4096}; pg8::StaticOrder S; S.init(MP, 1024, G, bx);
        pg8::EpiRes E{XB, rssB};
        pg8::gemm_phase<pg8::EpiRes, pg8::StaticOrder, true, true>(lds, tabs, g, S, E);
    }
    SEAM(11);
    if (IN(12)) {
        f32x4 gfv[4];
#pragma unroll
        for (int j = 0; j < 4; ++j) gfv[j] = ((const f32x4*)args.in[20])[64 * j + lane];
        for (int m0 = gw; m0 < M; m0 += 4 * NGW) {
            v2u xv[4][4]; float ps[4];
#pragma unroll
            for (int u = 0; u < 4; ++u) { const int m = m0 + u * NGW; if (m < M) { ps[u] = rssB[(size_t)m * 16 + (lane & 15)]; const v2u* xr = (const v2u*)(XB + (size_t)m * DM) + lane;
#pragma unroll
                for (int j = 0; j < 4; ++j) xv[u][j] = xr[64 * j]; } }
#pragma unroll
            for (int u = 0; u < 4; ++u) { const int m = m0 + u * NGW; if (m < M) { float p_ = ps[u]; p_ += __shfl_xor(p_, 1); p_ += __shfl_xor(p_, 2); p_ += __shfl_xor(p_, 4); p_ += __shfl_xor(p_, 8);
                const float rs = rsqrtf(p_ * (1.0f / 1024.0f) + EPS);
                f32x4* yo = (f32x4*)(m < MP ? out + OY_P + (size_t)m * DM : out + OY_S + (size_t)(m - MP) * DM) + lane;
#pragma unroll
                for (int j = 0; j < 4; ++j) { const v2u x = xv[u][j]; const f32x4 gg = gfv[j];
                    yo[64 * j] = (f32x4){bf_lo(x.x) * rs * gg[0], bf_hi(x.x) * rs * gg[1], bf_lo(x.y) * rs * gg[2], bf_hi(x.y) * rs * gg[3]}; } } }
        }
    }
#undef IN
#undef SEAM
#undef GRID_BAR
#undef ws
#undef out
#undef ctl
#undef lbv
#undef Wlf_t
#undef rssx
#undef rssA
#undef rssB
#undef Fs
#undef Win_t
#undef Wo_t
#undef Wup0_t
#undef Wdn0_t
#undef Wkvq_t
#undef Wob_t
#undef Wup1_t
#undef Wdn1_t
#undef XB
#undef S1
#undef S2
#undef S3
#undef S4
#undef S5
}

extern "C" void kernel_launch(void* const* d_in, const int* in_sizes, int n_in, void* d_out, int out_size, void* d_ws, size_t ws_size, hipStream_t stream) {
    static int grid = 0;
    if (grid == 0) {
        if (n_in != 21 || (size_t)out_size != OUT_END || ws_size < WS_END) { fprintf(stderr, "kernel_launch: unexpected shapes: n_in %d out %d ws %zu (need %zu)\n", n_in, out_size, ws_size, (size_t)WS_END); grid = -1; return; }
        int dev = 0, cus = 0, per_cu = 0;
        if (hipGetDevice(&dev) != hipSuccess || hipDeviceGetAttribute(&cus, hipDeviceAttributeMultiprocessorCount, dev) != hipSuccess) { grid = -1; return; }
        if (hipFuncSetAttribute((const void*)yoco_fwd, hipFuncAttributeMaxDynamicSharedMemorySize, LDS_BYTES) != hipSuccess) { fprintf(stderr, "kernel_launch: hipFuncSetAttribute failed\n"); grid = -1; return; }
        if (hipOccupancyMaxActiveBlocksPerMultiprocessor(&per_cu, (const void*)yoco_fwd, NWAVES * 64, LDS_BYTES) != hipSuccess || per_cu < 1) { fprintf(stderr, "kernel_launch: occupancy query reports %d blocks per CU\n", per_cu); }
        (void)hipGetLastError();
        grid = cus;
        fprintf(stderr, "kernel_launch: grid %d, occupancy %d per CU, ws %zu\n", grid, per_cu, ws_size);
    }
    if (grid < 0) return;
    if (hipMemsetAsync((char*)d_ws + WS_CTL, 0, CTL_ZERO_BYTES, stream) != hipSuccess) { fprintf(stderr, "kernel_launch: memset failed\n"); return; }
    Args a{};
    for (int i = 0; i < 21; ++i) a.in[i] = (const float*)d_in[i];
    a.out_ = (float*)d_out; a.ws_ = (unsigned char*)d_ws;
#ifndef PROBE_SPLIT
#define PROBE_SPLIT -1
#endif
    if (PROBE_SPLIT >= 0) {
        a.ph_lo = 0; a.ph_hi = PROBE_SPLIT + 1; a.dry_gla = (PROBE_SPLIT == 2); hipLaunchKernelGGL(yoco_fwd, dim3(grid), dim3(NWAVES * 64), LDS_BYTES, stream, a);
        (void)hipMemsetAsync((char*)d_ws + WS_CTL, 0, CTL_ZERO_BYTES, stream);
        a.ph_lo = PROBE_SPLIT; a.ph_hi = N_PHASES; a.dry_gla = 0; hipLaunchKernelGGL(yoco_fwd, dim3(grid), dim3(NWAVES * 64), LDS_BYTES, stream, a);
    } else if (N_LAUNCHES == 1) { a.ph_lo = 0; a.ph_hi = N_PHASES; hipLaunchKernelGGL(yoco_fwd, dim3(grid), dim3(NWAVES * 64), LDS_BYTES, stream, a); }
    else for (int p = 0; p < N_PHASES; ++p) { a.ph_lo = p; a.ph_hi = p + 1; hipLaunchKernelGGL(yoco_fwd, dim3(grid), dim3(NWAVES * 64), LDS_BYTES, stream, a); }
    const hipError_t le = hipPeekAtLastError();
    if (le != hipSuccess) fprintf(stderr, "kernel_launch: launch failed: %s\n", hipGetErrorName(le));
}
```
